# Optimizing an MI355X kernel written in HIP

```python
import math
import jax, jax.numpy as jnp
from jax import lax
import numpy as np

D_MODEL = 2048
BATCH = 8
SEQ = 4096
DEPTH = 4
DEC_BATCH = 2
DEC_SEQ = 4096
PAST_LEN = 128

HEAD_DIM = 128
GRID_W = 64
A_HEADS = 8
A_KV = 2
A_WINDOW = 128
B_HEADS = 8
B_KV = 2
ROPE_THETA = 10000.0
QBLK = 128
C_HEADS = 8
C_KV = 2
NA_ROWS = 8
NA_COLS = 16
NA_QCOLS = 16
NA_KSPAN = 32
D_PAIRS = ((128, 1), (512, 4), (2048, 16))
D_SLOTS = 4
D_HEADS = D_SLOTS * len(D_PAIRS)
T5_BUCKETS = 32
T5_MAX_DIST = 2048
T5_COLS = A_HEADS + D_HEADS
D_FF = 5632
NORM_EPS = 1e-6
NEG_INF = -1e30
ATTN_SCALE = HEAD_DIM ** -0.5

AB_SIZES = (A_HEADS * HEAD_DIM, A_KV * HEAD_DIM, A_KV * HEAD_DIM,
            B_HEADS * HEAD_DIM, B_KV * HEAD_DIM, B_KV * HEAD_DIM)
CD_SIZES = (C_HEADS * HEAD_DIM, C_KV * HEAD_DIM, C_KV * HEAD_DIM,
            D_HEADS * HEAD_DIM, D_SLOTS * HEAD_DIM, D_SLOTS * HEAD_DIM)
AB_IN = sum(AB_SIZES)
AB_OUT = (A_HEADS + B_HEADS) * HEAD_DIM
CD_IN = sum(CD_SIZES)
CD_OUT = (C_HEADS + D_SLOTS) * HEAD_DIM
N_EVEN = (DEPTH + 1) // 2
N_ODD = DEPTH // 2

kernel_name = 'hybrid_bidir_encoder_macaron'


def _rms_norm(x, g):
    xf = x.astype(jnp.float32)
    y = xf * lax.rsqrt(jnp.mean(xf * xf, axis=-1, keepdims=True) + NORM_EPS)
    return (y * g.astype(jnp.float32)).astype(x.dtype)


def _swiglu(x, w_in, w_out):
    gate, up = jnp.split(x @ w_in, 2, axis=-1)
    return (jax.nn.silu(gate) * up) @ w_out


def _split(x, sizes):
    idx = [int(i) for i in np.cumsum(sizes)[:-1]]
    return jnp.split(x, idx, axis=-1)


def _t5_bucket(rel):
    half = T5_BUCKETS // 2
    max_exact = half // 2
    n = jnp.abs(rel)
    nf = jnp.maximum(n, 1).astype(jnp.float32)
    large = max_exact + (jnp.log(nf / max_exact) / math.log(T5_MAX_DIST / max_exact)
                         * (half - max_exact)).astype(jnp.int32)
    large = jnp.minimum(large, half - 1)
    return jnp.where(rel > 0, half, 0) + jnp.where(n < max_exact, n, large)


def _t5_bias(table_cols, rel, n_kv):
    tb = table_cols.astype(jnp.float32)[_t5_bucket(rel)]
    h = table_cols.shape[1]
    return jnp.moveaxis(tb, -1, 0).reshape((n_kv, h // n_kv) + rel.shape)


def _band_rel(blk):
    iq = jnp.arange(blk)[:, None]
    j = jnp.arange(3 * blk)[None, :]
    return j - blk - iq


def _banded_attention(q, k, v, bias, band, blk):
    n, L, kv, g, dh = q.shape
    nb = -(-L // blk)
    pad = nb * blk - L
    qp = jnp.pad(q, ((0, 0), (0, pad), (0, 0), (0, 0), (0, 0)))
    kp = jnp.pad(k, ((0, 0), (blk, blk + pad), (0, 0), (0, 0)))
    vp = jnp.pad(v, ((0, 0), (blk, blk + pad), (0, 0), (0, 0)))
    idx = jnp.arange(nb)[:, None] * blk + jnp.arange(3 * blk)[None, :]
    kpos = idx - blk
    valid = band[None] & ((kpos >= 0) & (kpos < L))[:, None, :]
    kb = kp[:, idx]
    vb = vp[:, idx]
    qb = qp.reshape(n, nb, blk, kv, g, dh)
    s = jnp.einsum('nbqkgd,nbjkd->nbkgqj', qb, kb).astype(jnp.float32) * ATTN_SCALE + bias
    s = jnp.where(valid[None, :, None, None], s, NEG_INF)
    m = jnp.max(s, axis=-1, keepdims=True)
    p = jnp.exp(s - m)
    l = jnp.sum(p, axis=-1, keepdims=True)
    o = jnp.einsum('nbkgqj,nbjkd->nbqkgd', (p / l).astype(v.dtype), vb).astype(jnp.float32)
    lse = jnp.transpose((m + jnp.log(l))[..., 0], (0, 1, 4, 2, 3))
    o = o.reshape(n, nb * blk, kv, g, dh)[:, :L]
    lse = lse.reshape(n, nb * blk, kv, g)[:, :L]
    return o, lse


def _axial_rope(x, t):
    n_pairs = HEAD_DIM // 2
    n_freq = n_pairs // 2
    pos = jnp.arange(t)
    row = (pos // GRID_W).astype(jnp.float32)
    col = (pos % GRID_W).astype(jnp.float32)
    omega = ROPE_THETA ** (-(jnp.arange(n_freq, dtype=jnp.float32) * 2.0 / n_pairs))
    ang = jnp.concatenate([row[:, None] * omega, col[:, None] * omega], axis=-1)
    bshape = (1, t) + (1,) * (x.ndim - 3) + (n_pairs,)
    cos = jnp.cos(ang).reshape(bshape)
    sin = jnp.sin(ang).reshape(bshape)
    xr = x.astype(jnp.float32).reshape(x.shape[:-1] + (n_pairs, 2))
    x0, x1 = xr[..., 0], xr[..., 1]
    out = jnp.stack([x0 * cos - x1 * sin, x0 * sin + x1 * cos], axis=-1)
    return out.reshape(x.shape).astype(x.dtype)


def _dense_blocked(q, k, v):
    b, t = q.shape[:2]
    nb = t // QBLK
    qb = jnp.moveaxis(q.reshape((b, nb, QBLK) + q.shape[2:]), 1, 0)

    def one_block(qblk):
        s = jnp.einsum('bqkgd,btkd->bkgqt', qblk, k).astype(jnp.float32) * ATTN_SCALE
        p = jax.nn.softmax(s, axis=-1)
        return jnp.einsum('bkgqt,btkd->bqkgd', p.astype(v.dtype), v)

    o = lax.map(one_block, qb)
    return jnp.moveaxis(o, 0, 1).reshape(b, t, -1)


def _neighbourhood_attention(q, k, v, rpb):
    b, t, kvh, g, dh = q.shape
    rows = t // GRID_W
    kr = min(NA_ROWS, rows)
    ncb = GRID_W // NA_QCOLS
    r = jnp.arange(rows)
    rs = jnp.clip(r - NA_ROWS // 2, 0, rows - kr)
    row_idx = rs[:, None] + jnp.arange(kr)[None, :]
    jb = jnp.arange(ncb)
    span0 = jnp.clip(jb * NA_QCOLS - NA_COLS // 2, 0, GRID_W - NA_KSPAN)
    col_idx = span0[:, None] + jnp.arange(NA_KSPAN)[None, :]
    qc = jb[:, None] * NA_QCOLS + jnp.arange(NA_QCOLS)[None, :]
    cs = jnp.clip(qc - NA_COLS // 2, 0, GRID_W - NA_COLS)
    colmask = (col_idx[:, None, :] >= cs[..., None]) & (col_idx[:, None, :] < cs[..., None] + NA_COLS)
    nkeys = kr * NA_KSPAN
    mask = jnp.broadcast_to(colmask[:, :, None, :], (ncb, NA_QCOLS, kr, NA_KSPAN)).reshape(ncb, NA_QCOLS, nkeys)
    ri = row_idx[:, None, :, None]
    ci = col_idx[None, :, None, :]
    kg = k.reshape(b, rows, GRID_W, kvh, dh)[:, ri, ci].reshape(b, rows, ncb, nkeys, kvh, dh)
    vg = v.reshape(b, rows, GRID_W, kvh, dh)[:, ri, ci].reshape(b, rows, ncb, nkeys, kvh, dh)
    qg = q.reshape(b, rows, ncb, NA_QCOLS, kvh, g, dh)
    dr_i = (row_idx - r[:, None]) + NA_ROWS - 1
    dc_i = jnp.clip(col_idx[:, None, :] - qc[..., None] + NA_COLS - 1, 0, 2 * NA_COLS - 2)
    rb = rpb.astype(jnp.float32)[:, dr_i[:, None, None, :, None], dc_i[None, :, :, None, :]]
    rb = jnp.transpose(rb.reshape(kvh, g, rows, ncb, NA_QCOLS, nkeys), (2, 3, 0, 1, 4, 5))
    s = jnp.einsum('brjqkgd,brjnkd->brjkgqn', qg, kg).astype(jnp.float32) * ATTN_SCALE
    s = jnp.where(mask[None, None, :, None, None], s + rb[None], NEG_INF)
    p = jax.nn.softmax(s, axis=-1)
    o = jnp.einsum('brjkgqn,brjnkd->brjqkgd', p.astype(v.dtype), vg)
    return o.reshape(b, t, kvh * g * dh)


def _to_sub(a, d):
    b, t = a.shape[:2]
    a = a.reshape((b, t // d, d) + a.shape[2:])
    return jnp.swapaxes(a, 1, 2).reshape((b * d, t // d) + a.shape[3:])


def _from_sub(a, b, d):
    n, u = a.shape[:2]
    a = a.reshape((b, d, u) + a.shape[2:])
    return jnp.swapaxes(a, 1, 2).reshape((b, u * d) + a.shape[3:])


def _mixer_ab(h, w_in, sink, q_gain, k_gain, w_out, t5_table):
    b, t, _ = h.shape
    qa, ka, va, qb, kb, vb = _split(h @ w_in, AB_SIZES)
    ga = A_HEADS // A_KV
    qa = qa.reshape(b, t, A_KV, ga, HEAD_DIM)
    ka = ka.reshape(b, t, A_KV, HEAD_DIM)
    va = va.reshape(b, t, A_KV, HEAD_DIM)
    rel = _band_rel(A_WINDOW)
    band = jnp.abs(rel) <= A_WINDOW
    bias_a = _t5_bias(t5_table[:, :A_HEADS], rel, A_KV)
    o_a, lse_a = _banded_attention(qa, ka, va, bias_a, band, A_WINDOW)
    keep = jax.nn.sigmoid(lse_a - sink.astype(jnp.float32).reshape(A_KV, ga))
    o_a = (o_a * keep[..., None]).astype(h.dtype).reshape(b, t, -1)
    gb = B_HEADS // B_KV
    qb = _axial_rope(_rms_norm(qb.reshape(b, t, B_KV, gb, HEAD_DIM), q_gain), t)
    kb = _axial_rope(_rms_norm(kb.reshape(b, t, B_KV, HEAD_DIM), k_gain), t)
    o_b = _dense_blocked(qb, kb, vb.reshape(b, t, B_KV, HEAD_DIM)).astype(h.dtype)
    return jnp.concatenate([o_a, o_b], axis=-1) @ w_out


def _mixer_cd(h, w_in, rpb, w_out, t5_table):
    b, t, _ = h.shape
    qc, kc, vc, qd, kd, vd = _split(h @ w_in, CD_SIZES)
    gc = C_HEADS // C_KV
    o_c = _neighbourhood_attention(qc.reshape(b, t, C_KV, gc, HEAD_DIM),
                                   kc.reshape(b, t, C_KV, HEAD_DIM),
                                   vc.reshape(b, t, C_KV, HEAD_DIM), rpb).astype(h.dtype)
    qd = qd.reshape(b, t, len(D_PAIRS), D_SLOTS, 1, HEAD_DIM)
    kd = kd.reshape(b, t, D_SLOTS, HEAD_DIM)
    vd = vd.reshape(b, t, D_SLOTS, HEAD_DIM)
    outs, lses = [], []
    for gi, (win, dil) in enumerate(D_PAIRS):
        hs = win // (2 * dil)
        rel_sub = _band_rel(hs)
        band = jnp.abs(rel_sub) <= hs
        col0 = A_HEADS + gi * D_SLOTS
        bias_g = _t5_bias(t5_table[:, col0:col0 + D_SLOTS], rel_sub * dil, D_SLOTS)
        o_g, lse_g = _banded_attention(_to_sub(qd[:, :, gi], dil), _to_sub(kd, dil),
                                       _to_sub(vd, dil), bias_g, band, hs)
        outs.append(_from_sub(o_g, b, dil))
        lses.append(_from_sub(lse_g, b, dil))
    wts = jax.nn.softmax(jnp.stack(lses), axis=0)
    o_d = jnp.sum(wts[..., None] * jnp.stack(outs), axis=0).astype(h.dtype).reshape(b, t, -1)
    return jnp.concatenate([o_c, o_d], axis=-1) @ w_out


def _trunk(x, p):
    for l in range(DEPTH):
        i = l // 2
        x = x + 0.5 * _swiglu(_rms_norm(x, p['norm_ffn1'][l]), p['ffn1_w_in'][l], p['ffn1_w_out'][l])
        hn = _rms_norm(x, p['norm_mix'][l])
        if l % 2 == 0:
            x = x + _mixer_ab(hn, p['ab_w_in'][i], p['ab_sink'][i], p['ab_q_gain'][i],
                              p['ab_k_gain'][i], p['ab_w_out'][i], p['t5_table'])
        else:
            x = x + _mixer_cd(hn, p['cd_w_in'][i], p['cd_rpb'][i], p['cd_w_out'][i], p['t5_table'])
        x = x + 0.5 * _swiglu(_rms_norm(x, p['norm_ffn2'][l]), p['ffn2_w_in'][l], p['ffn2_w_out'][l])
    return _rms_norm(x, p['final_norm'])


def setup_inputs(seed: int = 0) -> dict:
    key = jax.random.key(seed)
    ks = jax.random.split(key, 20)
    f32 = jnp.float32

    def w(k, shape, fan_in):
        return jax.random.normal(k, shape, f32) * fan_in ** -0.5

    def gain(k, shape):
        return 1.0 + 0.02 * jax.random.normal(k, shape, f32)

    return {
        'x_prompt': jax.random.normal(ks[0], (BATCH, SEQ, D_MODEL), f32),
        'x_sample': jax.random.normal(ks[1], (DEC_BATCH, DEC_SEQ, D_MODEL), f32),
        'norm_ffn1': gain(ks[2], (DEPTH, D_MODEL)),
        'ffn1_w_in': w(ks[3], (DEPTH, D_MODEL, 2 * D_FF), D_MODEL),
        'ffn1_w_out': w(ks[4], (DEPTH, D_FF, D_MODEL), D_FF),
        'norm_mix': gain(ks[5], (DEPTH, D_MODEL)),
        'ab_w_in': w(ks[6], (N_EVEN, D_MODEL, AB_IN), D_MODEL),
        'ab_sink': jax.random.normal(ks[7], (N_EVEN, A_HEADS), f32),
        'ab_q_gain': gain(ks[8], (N_EVEN, HEAD_DIM)),
        'ab_k_gain': gain(ks[9], (N_EVEN, HEAD_DIM)),
        'ab_w_out': w(ks[10], (N_EVEN, AB_OUT, D_MODEL), AB_OUT),
        'cd_w_in': w(ks[11], (N_ODD, D_MODEL, CD_IN), D_MODEL),
        'cd_rpb': 0.1 * jax.random.normal(ks[12], (N_ODD, C_HEADS, 2 * NA_ROWS - 1, 2 * NA_COLS - 1), f32),
        'cd_w_out': w(ks[13], (N_ODD, CD_OUT, D_MODEL), CD_OUT),
        'norm_ffn2': gain(ks[14], (DEPTH, D_MODEL)),
        'ffn2_w_in': w(ks[15], (DEPTH, D_MODEL, 2 * D_FF), D_MODEL),
        'ffn2_w_out': w(ks[16], (DEPTH, D_FF, D_MODEL), D_FF),
        't5_table': 0.1 * jax.random.normal(ks[17], (T5_BUCKETS, T5_COLS), f32),
        'final_norm': gain(ks[18], (D_MODEL,)),
    }


def reference(x_prompt, x_sample, norm_ffn1, ffn1_w_in, ffn1_w_out, norm_mix, ab_w_in, ab_sink,
              ab_q_gain, ab_k_gain, ab_w_out, cd_w_in, cd_rpb, cd_w_out, norm_ffn2, ffn2_w_in,
              ffn2_w_out, t5_table, final_norm):
    params = {
        'norm_ffn1': norm_ffn1, 'ffn1_w_in': ffn1_w_in, 'ffn1_w_out': ffn1_w_out,
        'norm_mix': norm_mix, 'ab_w_in': ab_w_in, 'ab_sink': ab_sink,
        'ab_q_gain': ab_q_gain, 'ab_k_gain': ab_k_gain, 'ab_w_out': ab_w_out,
        'cd_w_in': cd_w_in, 'cd_rpb': cd_rpb, 'cd_w_out': cd_w_out,
        'norm_ffn2': norm_ffn2, 'ffn2_w_in': ffn2_w_in, 'ffn2_w_out': ffn2_w_out,
        't5_table': t5_table, 'final_norm': final_norm,
    }
    y_prompt = _trunk(x_prompt, params)
    y_sample = _trunk(x_sample, params)
    return (y_prompt, y_sample)
```

```cpp
#include <hip/hip_runtime.h>
#include <cstdio>
#include <cstdint>

#ifndef EN_MASK
#define EN_MASK 0xFFFF
#endif
#define EN(b) ((EN_MASK >> (b)) & 1)
#ifndef REP_MASK
#define REP_MASK 0
#endif
#define NREP(b) (((REP_MASK >> (b)) & 1) ? 2 : 1)
#ifndef MK_PER_PHASE
#define MK_PER_PHASE 0
#endif

namespace pg8 {
#define PG8_LAS __attribute__((address_space(3)))
typedef unsigned short bf16_t;
typedef short bf16x8 __attribute__((ext_vector_type(8)));
typedef float f32x4 __attribute__((ext_vector_type(4)));
typedef unsigned u32x4 __attribute__((ext_vector_type(4)));
constexpr int BM = 256, BK = 64, HALF = 128, HTB = HALF * BK * 2, STAGE_BYTES = 8 * HTB, NXCD = 8, WGM = 8;

__host__ __device__ __forceinline__ int lds_byte(int r, int c) { const int st = (r >> 4) * 2 + (c >> 5), rr = r & 15, cc = c & 31, ob = rr * 64 + cc * 2; return st * 1024 + (ob ^ (((ob >> 9) & 1) << 5)); }
__host__ __device__ __forceinline__ void stage_rc(int b, int& R, int& C) { const int st = b / 1024, sb = b % 1024, swz = sb ^ (((sb >> 9) & 1) << 5); R = (st >> 1) * 16 + swz / 64; C = (st & 1) * 32 + (swz % 64) / 2; }
__host__ __device__ __forceinline__ int perm32(int rho) { const int n = rho >> 4, i = rho & 15; return 8 * (i >> 2) + 4 * n + (i & 3); }

struct Unit { int pm, pn; };
struct Gemm { const bf16_t* A; const bf16_t* Bt; int M, N, K; };

struct StaticOrder {
    int nM, nN, nwg, G, c, wgm;
    __host__ __device__ void init(int M, int N, int G_, int c_, int wgm_ = WGM) { nM = M / BM; nN = N / BM; nwg = nM * nN; G = G_; c = c_; wgm = wgm_; }
    __host__ __device__ bool next(int i, Unit& u) const {
        const long L = (long)i * G + c; if (L >= nwg) return false;
        int wgid = (int)L; { const int q = nwg / NXCD, r = nwg % NXCD, xcd = wgid % NXCD, off = wgid / NXCD; wgid = (xcd < r ? xcd * (q + 1) : r * (q + 1) + (xcd - r) * q) + off; }
        const int nig = wgm * nN, gid = wgid / nig, fm = gid * wgm, gsz = (nM - fm) < wgm ? (nM - fm) : wgm;
        u.pm = fm + ((wgid % nig) % gsz); u.pn = (wgid % nig) / gsz; return true;
    }
    __device__ __forceinline__ void a_ready(const Unit&) const {}
    __device__ __forceinline__ void done(const Unit&) const {}
};

__device__ __forceinline__ unsigned cvt_pk_bf16(float lo, float hi) { unsigned r; asm volatile("v_cvt_pk_bf16_f32 %0, %1, %2" : "=v"(r) : "v"(lo), "v"(hi)); return r; }

struct EpiBf16 {
    static constexpr bool PERM = true, AFTER_DRAIN = false;
    bf16_t* O; int ldc;
    __device__ __forceinline__ void operator()(const f32x4 (&acc)[2][2][4][2], const Unit& u, int wr, int wc, int fr, int fq) const {
        const int row0 = u.pm * BM + wr * 64 + fr, col0 = u.pn * BM + wc * 32 + 8 * fq;
#pragma unroll
        for (int ai = 0; ai < 2; ++ai)
#pragma unroll
            for (int m = 0; m < 4; ++m) { bf16_t* rowp = O + (size_t)(row0 + ai * HALF + m * 16) * ldc + col0;
#pragma unroll
                for (int bj = 0; bj < 2; ++bj) { const f32x4 v0 = acc[ai][bj][m][0], v1 = acc[ai][bj][m][1];
                    u32x4 w; w.x = cvt_pk_bf16(v0[0], v0[1]); w.y = cvt_pk_bf16(v0[2], v0[3]); w.z = cvt_pk_bf16(v1[0], v1[1]); w.w = cvt_pk_bf16(v1[2], v1[3]);
                    *(u32x4*)(rowp + bj * HALF) = w; } }
    }
};
struct EpiSwiGLU {
    static constexpr bool PERM = true, AFTER_DRAIN = false;
    bf16_t* O; int ldc;
    __device__ __forceinline__ static float act(float g, float u) { return g * __builtin_amdgcn_rcpf(1.0f + __builtin_amdgcn_exp2f(-1.4426950408889634f * g)) * u; }
    __device__ __forceinline__ void operator()(const f32x4 (&acc)[2][2][4][2], const Unit& u, int wr, int wc, int fr, int fq) const {
        const int row0 = u.pm * BM + wr * 64 + fr, col0 = u.pn * HALF + wc * 32 + 8 * fq;
#pragma unroll
        for (int ai = 0; ai < 2; ++ai)
#pragma unroll
            for (int m = 0; m < 4; ++m) { bf16_t* rowp = O + (size_t)(row0 + ai * HALF + m * 16) * ldc + col0;
                const f32x4 g0 = acc[ai][0][m][0], g1 = acc[ai][0][m][1], u0 = acc[ai][1][m][0], u1 = acc[ai][1][m][1];
                u32x4 w; w.x = cvt_pk_bf16(act(g0[0], u0[0]), act(g0[1], u0[1])); w.y = cvt_pk_bf16(act(g0[2], u0[2]), act(g0[3], u0[3]));
                w.z = cvt_pk_bf16(act(g1[0], u1[0]), act(g1[1], u1[1])); w.w = cvt_pk_bf16(act(g1[2], u1[2]), act(g1[3], u1[3]));
                *(u32x4*)rowp = w; }
    }
};
struct EpiDelta {
    static constexpr bool PERM = true, AFTER_DRAIN = false;
    bf16_t* O; int ldc; float alpha;
    __device__ __forceinline__ void operator()(const f32x4 (&acc)[2][2][4][2], const Unit& u, int wr, int wc, int fr, int fq) const {
        const int row0 = u.pm * BM + wr * 64 + fr, col0 = u.pn * BM + wc * 32 + 8 * fq;
#pragma unroll
        for (int ai = 0; ai < 2; ++ai)
#pragma unroll
            for (int m = 0; m < 4; ++m) { bf16_t* rowp = O + (size_t)(row0 + ai * HALF + m * 16) * ldc + col0;
#pragma unroll
                for (int bj = 0; bj < 2; ++bj) { const f32x4 v0 = acc[ai][bj][m][0] * alpha, v1 = acc[ai][bj][m][1] * alpha;
                    u32x4 w; w.x = cvt_pk_bf16(v0[0], v0[1]); w.y = cvt_pk_bf16(v0[2], v0[3]); w.z = cvt_pk_bf16(v1[0], v1[1]); w.w = cvt_pk_bf16(v1[2], v1[3]);
                    *(u32x4*)(rowp + bj * HALF) = w; } }
    }
};

template <class Epi, class Sched, bool ALIGN_EPI = false, bool SP2 = false>
__device__ __forceinline__ void gemm_phase(PG8_LAS unsigned char* lds, const Gemm g, const Sched& S, const Epi& E) {
    int tid = threadIdx.x; asm volatile("" : "+v"(tid));
    const int wid = __builtin_amdgcn_readfirstlane(tid >> 6), lane = tid & 63, wr = wid >> 2, wc = wid & 3, fr = lane & 15, fq = lane >> 4;
    const int K = g.K, nt = K / BK;
    unsigned voffA[2], voffB[2];
#pragma unroll
    for (int i = 0; i < 2; ++i) { int R, C; stage_rc(tid * 16 + i * 8192, R, C); const int Rb = Epi::PERM ? ((R & ~31) + perm32(R & 31)) : R;
        voffA[i] = (unsigned)(R * K + C) * 2u; voffB[i] = (unsigned)(Rb * K + C) * 2u; }
    const size_t kstep = (size_t)(BK * 2);
    const size_t hstep = (size_t)HALF * K * 2;
    const size_t tstep = 2 * hstep;
    const unsigned ldsw = (unsigned)wid * 1024u;
    const int aoff = lds_byte(wr * 64 + fr, fq * 8), boff = lds_byte(wc * 32 + fr, fq * 8);
#define PG8_SA(b, h) (((b) * 2 + (h)) * HTB)
#define PG8_SB(b, h) ((4 + (b) * 2 + (h)) * HTB)
#define PG8_STAGE(bufoff, gbase, voff) do { _Pragma("unroll") for (int _i = 0; _i < 2; ++_i) \
        __builtin_amdgcn_global_load_lds((const unsigned*)((const char*)(gbase) + (voff)[_i]), (PG8_LAS unsigned*)(lds + (bufoff) + ldsw + _i * 8192), 16, 0, 0); } while (0)
#define PG8_LDA(dst, b, h) do { _Pragma("unroll") for (int m = 0; m < 4; ++m) _Pragma("unroll") for (int k = 0; k < 2; ++k) dst[m][k] = *(const PG8_LAS bf16x8*)(lds + PG8_SA(b, h) + aoff + m * 2048 + k * 1024); } while (0)
#define PG8_LDB(dst, b, h) do { _Pragma("unroll") for (int n = 0; n < 2; ++n) _Pragma("unroll") for (int k = 0; k < 2; ++k) dst[n][k] = *(const PG8_LAS bf16x8*)(lds + PG8_SB(b, h) + boff + n * 2048 + k * 1024); } while (0)
#define PG8_MMA(ai, bj, At, Bt) do { __builtin_amdgcn_s_setprio(1); _Pragma("unroll") for (int m = 0; m < 4; ++m) _Pragma("unroll") for (int n = 0; n < 2; ++n) _Pragma("unroll") for (int k = 0; k < 2; ++k) \
        acc[ai][bj][m][n] = __builtin_amdgcn_mfma_f32_16x16x32_bf16(Bt[n][k], At[m][k], acc[ai][bj][m][n], 0, 0, 0); __builtin_amdgcn_s_setprio(0); } while (0)
#define PG8_WAIT_V(n) asm volatile("s_waitcnt vmcnt(" #n ")" ::: "memory")
#define PG8_WAIT_L(n) asm volatile("s_waitcnt lgkmcnt(" #n ")" ::: "memory")
#define PG8_BAR __builtin_amdgcn_s_barrier()
#define PG8_SCHED __builtin_amdgcn_sched_barrier(0)
    Unit cur, nxt; int ui = 0;
    if (!S.next(0, cur)) return;
    f32x4 acc[2][2][4][2];
#pragma unroll
    for (int a = 0; a < 2; ++a)
#pragma unroll
        for (int b = 0; b < 2; ++b)
#pragma unroll
            for (int m = 0; m < 4; ++m)
#pragma unroll
                for (int n = 0; n < 2; ++n) acc[a][b][m][n] = (f32x4){0.f, 0.f, 0.f, 0.f};
    bf16x8 At[4][2], B0[2][2], B1[2][2];
    const char* cA = (const char*)g.A + (size_t)cur.pm * tstep; const char* cB = (const char*)g.Bt + (size_t)cur.pn * tstep;
    S.a_ready(cur);
    if constexpr (SP2) {
        PG8_STAGE(PG8_SB(0, 0), cB, voffB); PG8_STAGE(PG8_SB(0, 1), cB + hstep, voffB); PG8_STAGE(PG8_SA(0, 0), cA, voffA); PG8_STAGE(PG8_SA(0, 1), cA + hstep, voffA);
        if (wr == 1) PG8_BAR;
        PG8_WAIT_V(2); PG8_BAR;
        PG8_STAGE(PG8_SB(1, 0), cB + kstep, voffB); PG8_STAGE(PG8_SA(1, 0), cA + kstep, voffA); PG8_STAGE(PG8_SB(1, 1), cB + hstep + kstep, voffB);
        PG8_WAIT_V(6); PG8_BAR;
    } else {
        PG8_STAGE(PG8_SB(0, 0), cB, voffB); PG8_STAGE(PG8_SA(0, 0), cA, voffA); PG8_STAGE(PG8_SB(0, 1), cB + hstep, voffB); PG8_STAGE(PG8_SA(0, 1), cA + hstep, voffA);
        if (wr == 1) PG8_BAR;
        PG8_WAIT_V(4); PG8_BAR;
        PG8_STAGE(PG8_SB(1, 0), cB + kstep, voffB); PG8_STAGE(PG8_SA(1, 0), cA + kstep, voffA); PG8_STAGE(PG8_SB(1, 1), cB + hstep + kstep, voffB);
        PG8_WAIT_V(6); PG8_BAR;
    }
    for (;;) {
        const bool has_next = S.next(ui + 1, nxt);
        const char* nA = has_next ? (const char*)g.A + (size_t)nxt.pm * tstep : cA; const char* nB = has_next ? (const char*)g.Bt + (size_t)nxt.pn * tstep : cB;
        for (int t = 0; t < nt; t += 2) {
            const bool last = (t == nt - 2);
            const char* a1 = cA + (size_t)(t + 1) * kstep;
            const char* a2 = last ? nA : cA + (size_t)(t + 2) * kstep; const char* b2 = last ? nB : cB + (size_t)(t + 2) * kstep;
            const char* a3 = a2 + kstep; const char* b3 = b2 + kstep;
            if (last && has_next) S.a_ready(nxt);
            if constexpr (SP2) {
            PG8_LDB(B0, 0, 0); PG8_LDB(B1, 0, 1); PG8_SCHED; PG8_LDA(At, 0, 0); PG8_STAGE(PG8_SA(1, 1), a1 + hstep, voffA);
            PG8_WAIT_V(8); PG8_WAIT_L(0); PG8_BAR; PG8_MMA(0, 0, At, B0); PG8_MMA(0, 1, At, B1); PG8_BAR; PG8_SCHED;
            PG8_LDA(At, 0, 1); PG8_STAGE(PG8_SB(0, 0), b2, voffB); PG8_STAGE(PG8_SB(0, 1), b2 + hstep, voffB); PG8_STAGE(PG8_SA(0, 0), a2, voffA);
            PG8_WAIT_V(8); PG8_WAIT_L(0); PG8_BAR; PG8_MMA(1, 0, At, B0); PG8_MMA(1, 1, At, B1); PG8_BAR; PG8_SCHED;
            PG8_LDB(B0, 1, 0); PG8_LDB(B1, 1, 1); PG8_SCHED; PG8_LDA(At, 1, 0); PG8_STAGE(PG8_SA(0, 1), a2 + hstep, voffA);
            PG8_WAIT_V(8); PG8_WAIT_L(0); PG8_BAR; PG8_MMA(0, 0, At, B0); PG8_MMA(0, 1, At, B1); PG8_BAR; PG8_SCHED;
            PG8_LDA(At, 1, 1); PG8_STAGE(PG8_SB(1, 0), b3, voffB); PG8_STAGE(PG8_SB(1, 1), b3 + hstep, voffB); PG8_STAGE(PG8_SA(1, 0), a3, voffA);
            PG8_WAIT_V(8); PG8_WAIT_L(0); PG8_BAR; PG8_MMA(1, 0, At, B0); PG8_MMA(1, 1, At, B1); PG8_BAR; PG8_SCHED;
            } else {
            PG8_LDB(B0, 0, 0); PG8_SCHED; PG8_LDA(At, 0, 0); PG8_STAGE(PG8_SA(1, 1), a1 + hstep, voffA);
            PG8_WAIT_L(8); PG8_BAR; PG8_WAIT_L(0); PG8_MMA(0, 0, At, B0); PG8_BAR; PG8_SCHED;
            PG8_LDB(B1, 0, 1); PG8_STAGE(PG8_SB(0, 0), b2, voffB);
            PG8_BAR; PG8_WAIT_L(0); PG8_MMA(0, 1, At, B1); PG8_BAR;
            PG8_LDA(At, 0, 1); PG8_STAGE(PG8_SA(0, 0), a2, voffA);
            PG8_BAR; PG8_WAIT_L(0); PG8_MMA(1, 0, At, B0); PG8_BAR; PG8_SCHED;
            PG8_STAGE(PG8_SB(0, 1), b2 + hstep, voffB);
            PG8_WAIT_V(6); PG8_BAR; PG8_MMA(1, 1, At, B1); PG8_BAR;
            PG8_LDB(B0, 1, 0); PG8_SCHED; PG8_LDA(At, 1, 0); PG8_STAGE(PG8_SA(0, 1), a2 + hstep, voffA);
            PG8_WAIT_L(8); PG8_BAR; PG8_WAIT_L(0); PG8_MMA(0, 0, At, B0); PG8_BAR; PG8_SCHED;
            PG8_LDB(B1, 1, 1); PG8_STAGE(PG8_SB(1, 0), b3, voffB);
            PG8_BAR; PG8_WAIT_L(0); PG8_MMA(0, 1, At, B1); PG8_BAR;
            PG8_LDA(At, 1, 1); PG8_STAGE(PG8_SA(1, 0), a3, voffA);
            PG8_BAR; PG8_WAIT_L(0); PG8_MMA(1, 0, At, B0); PG8_BAR; PG8_SCHED;
            PG8_STAGE(PG8_SB(1, 1), b3 + hstep, voffB);
            PG8_WAIT_V(6); PG8_BAR; PG8_MMA(1, 1, At, B1); PG8_BAR;
            }
        }
        if constexpr (ALIGN_EPI) { if (wr == 0) PG8_BAR; }
        if constexpr (!Epi::AFTER_DRAIN) { E(acc, cur, wr, wc, fr, fq); S.done(cur); }
        if (!has_next) break;
#pragma unroll
        for (int a = 0; a < 2; ++a)
#pragma unroll
            for (int b = 0; b < 2; ++b)
#pragma unroll
                for (int m = 0; m < 4; ++m)
#pragma unroll
                    for (int n = 0; n < 2; ++n) acc[a][b][m][n] = (f32x4){0.f, 0.f, 0.f, 0.f};
        cur = nxt; cA = nA; cB = nB; ++ui;
        if constexpr (ALIGN_EPI) { if (wr == 1) PG8_BAR; }
    }
    PG8_WAIT_V(0);
    if constexpr (!ALIGN_EPI) { if (wr == 0) PG8_BAR; }
    PG8_BAR;
#undef PG8_SA
#undef PG8_SB
#undef PG8_STAGE
#undef PG8_LDA
#undef PG8_LDB
#undef PG8_MMA
#undef PG8_WAIT_V
#undef PG8_WAIT_L
#undef PG8_BAR
#undef PG8_SCHED
}
}

constexpr int DM = 2048, NSEQ = 10, SEQ = 4096, MTOK = NSEQ * SEQ  , MPROMPT = 8 * SEQ, DEPTH = 4, DFF = 5632, HD = 128;
constexpr int AB_IN = 3072, AB_OUT = 2048, CD_IN = 4096, CD_OUT = 1536;
constexpr float NORM_EPS = 1e-6f;

#define GAS __attribute__((address_space(1)))
#define LAS __attribute__((address_space(3)))
typedef unsigned short bf16;
typedef unsigned v4u __attribute__((ext_vector_type(4)));
typedef unsigned v2u __attribute__((ext_vector_type(2)));
typedef float f32x4 __attribute__((ext_vector_type(4)));
#define LDS_WAIT() asm volatile("s_waitcnt lgkmcnt(0)" ::: "memory")
#define VM_WAIT() asm volatile("s_waitcnt vmcnt(0)" ::: "memory")
__device__ __forceinline__ unsigned pk2(float lo, float hi) { unsigned r; asm("v_cvt_pk_bf16_f32 %0, %1, %2" : "=v"(r) : "v"(lo), "v"(hi)); return r; }
__device__ __forceinline__ unsigned f2bf(float f) { return pk2(f, 0.f) & 0xffffu; }
typedef _Float16 h2_t __attribute__((ext_vector_type(2)));
__device__ __forceinline__ unsigned pk2h(float lo, float hi) { h2_t v; v.x = (_Float16)lo; v.y = (_Float16)hi; return __builtin_bit_cast(unsigned, v); }
__device__ __forceinline__ float hlo(unsigned w) { return (float)__builtin_bit_cast(h2_t, w).x; }
__device__ __forceinline__ float hhi(unsigned w) { return (float)__builtin_bit_cast(h2_t, w).y; }
__device__ __forceinline__ float bflo(unsigned w) { return __builtin_bit_cast(float, w << 16); }
__device__ __forceinline__ float bfhi(unsigned w) { return __builtin_bit_cast(float, w & 0xffff0000u); }

namespace att {
using bf16x8 = __attribute__((ext_vector_type(8))) short;
using s16x4  = __attribute__((ext_vector_type(4))) short;
using f32x16 = __attribute__((ext_vector_type(16))) float;
using u32x4  = __attribute__((ext_vector_type(4))) unsigned;
constexpr int D = 128, NW = 8, QBLK = 32, KVBLK = 64;
constexpr float SCALE = 0.088388347648318440f, LOG2E = 1.4426950408889634f, THR = 8.f, NEG = -1e30f;
constexpr int SHM_V = KVBLK * D * 2, SHM_K = KVBLK * D * 2;
constexpr int WS_OFF = 2 * SHM_V + 2 * SHM_K;
constexpr int TAB_OFF = WS_OFF + NW * 64 * 4;
constexpr int ATT_LDS = TAB_OFF + 8192;
#define KSWZ(row, colB) ((row) * 256 + ((colB) ^ (((row) & 7) << 4)))
#define SBAR() __builtin_amdgcn_sched_barrier(0)
__device__ __forceinline__ int crow(int r, int hi) { return (r & 3) + 8 * (r >> 2) + 4 * hi; }
__device__ __forceinline__ unsigned cvtpk(float lo, float hi) { unsigned r; asm volatile("v_cvt_pk_bf16_f32 %0, %1, %2" : "=v"(r) : "v"(lo), "v"(hi)); return r; }
__device__ __forceinline__ bf16x8 ld8(const bf16* p) { return *reinterpret_cast<const bf16x8*>(p); }

template <bool NAT>
__device__ __forceinline__ void partialSM(f32x16& p0, f32x16& p1, float& m_reg, float& mn, float& alpha) {
  constexpr float C = NAT ? LOG2E : SCALE * LOG2E;
  constexpr float T = NAT ? THR : THR / SCALE;
  float pmax = p0[0];
#pragma unroll
  for (int r = 1; r < 16; ++r) pmax = fmaxf(pmax, p0[r]);
#pragma unroll
  for (int r = 0; r < 16; ++r) pmax = fmaxf(pmax, p1[r]);
  { auto rr = __builtin_amdgcn_permlane32_swap(__float_as_uint(pmax), __float_as_uint(pmax), false, false);
    pmax = fmaxf(__uint_as_float(rr[0]), __uint_as_float(rr[1])); }
  if (__builtin_expect(__all(pmax - m_reg <= T), 1)) { mn = m_reg; alpha = 1.f; }
  else { mn = fmaxf(m_reg, pmax); alpha = __builtin_amdgcn_exp2f((m_reg - mn) * C); m_reg = mn; }
  if constexpr (NAT) {
#pragma unroll
    for (int r = 0; r < 16; ++r) p0[r] = (p0[r] - mn) * C;
#pragma unroll
    for (int r = 0; r < 16; ++r) p1[r] = (p1[r] - mn) * C;
  } else {
    const float mnC = -mn * C;
#pragma unroll
    for (int r = 0; r < 16; ++r) p0[r] = fmaf(p0[r], C, mnC);
#pragma unroll
    for (int r = 0; r < 16; ++r) p1[r] = fmaf(p1[r], C, mnC);
  }
#pragma unroll
  for (int r = 0; r < 16; ++r) p0[r] = __builtin_amdgcn_exp2f(p0[r]);
}
__device__ __forceinline__ void finishSM(f32x16& p0, f32x16& p1, float alpha, float& l_reg, bf16x8& pa0, bf16x8& pa1, bf16x8& pa2, bf16x8& pa3) {
#pragma unroll
  for (int r = 0; r < 16; ++r) p1[r] = __builtin_amdgcn_exp2f(p1[r]);
  float ps = 0;
#pragma unroll
  for (int r = 0; r < 16; ++r) ps += p0[r];
#pragma unroll
  for (int r = 0; r < 16; ++r) ps += p1[r];
  { auto rr = __builtin_amdgcn_permlane32_swap(__float_as_uint(ps), __float_as_uint(ps), false, false);
    ps = __uint_as_float(rr[0]) + __uint_as_float(rr[1]); }
  l_reg = l_reg * alpha + ps;
#define PK4(P, BASE, OUT) do { unsigned a0 = cvtpk(P[BASE + 0], P[BASE + 1]), a1 = cvtpk(P[BASE + 2], P[BASE + 3]);   \
    unsigned b0 = cvtpk(P[BASE + 4], P[BASE + 5]), b1 = cvtpk(P[BASE + 6], P[BASE + 7]);                              \
    auto r0 = __builtin_amdgcn_permlane32_swap(a0, b0, false, false); auto r1 = __builtin_amdgcn_permlane32_swap(a1, b1, false, false); \
    u32x4 w = {r0[0], r1[0], r0[1], r1[1]}; OUT = *reinterpret_cast<bf16x8*>(&w); } while (0)
  PK4(p0, 0, pa0); PK4(p0, 8, pa1); PK4(p1, 0, pa2); PK4(p1, 8, pa3);
#undef PK4
}
__device__ __forceinline__ void qkt(f32x16& p0, f32x16& p1, const LAS char* Ks, const bf16x8* qr, int r32, int hi) {
  p0 = f32x16{}; p1 = f32x16{};
#pragma unroll
  for (int d0 = 0; d0 < 8; ++d0) { const int cb = (d0 * 16 + hi * 8) * 2;
    bf16x8 b0 = *reinterpret_cast<const LAS bf16x8*>(Ks + KSWZ(r32, cb));
    bf16x8 b1 = *reinterpret_cast<const LAS bf16x8*>(Ks + KSWZ(32 + r32, cb));
    p0 = __builtin_amdgcn_mfma_f32_32x32x16_bf16(b0, qr[d0], p0, 0, 0, 0);
    p1 = __builtin_amdgcn_mfma_f32_32x32x16_bf16(b1, qr[d0], p1, 0, 0, 0); }
}
__device__ __forceinline__ int v_st(int k, int c) { const int kk = (k & ~0xC) | ((k & 4) << 1) | ((k & 8) >> 1); return ((kk >> 3) * 4 + (c >> 5)) * 512 + ((kk & 7) * 32 + (c & 31)) * 2; }
__device__ __forceinline__ int v_rd_base(int lane) { return ((lane & 3) << 3) | (((lane >> 2) & 3) << 6) | (((lane >> 4) & 1) << 5) | (((lane >> 5) & 1) << 8); }
constexpr int v_rd_off(int d0, int ks, int half) { return d0 * 512 + ks * 4096 + half * 2048; }
template <int OFF> __device__ __forceinline__ s16x4 tr_read(int vb) {
  s16x4 r; asm volatile("ds_read_b64_tr_b16 %0, %1 offset:%2" : "=&v"(r) : "v"(vb), "i"(OFF) : "memory"); return r;
}
template <int D0> __device__ __forceinline__ void pv_one(f32x16& od, int vb, bf16x8 pa0, bf16x8 pa1, bf16x8 pa2, bf16x8 pa3) {
  const s16x4 l0 = tr_read<v_rd_off(D0, 0, 0)>(vb), h0 = tr_read<v_rd_off(D0, 0, 1)>(vb), l1 = tr_read<v_rd_off(D0, 1, 0)>(vb), h1 = tr_read<v_rd_off(D0, 1, 1)>(vb);
  const s16x4 l2 = tr_read<v_rd_off(D0, 2, 0)>(vb), h2 = tr_read<v_rd_off(D0, 2, 1)>(vb), l3 = tr_read<v_rd_off(D0, 3, 0)>(vb), h3 = tr_read<v_rd_off(D0, 3, 1)>(vb);
  asm volatile("s_waitcnt lgkmcnt(0)" ::: "memory"); SBAR();
#define PK(L, H) (bf16x8){L[0], L[1], L[2], L[3], H[0], H[1], H[2], H[3]}
  od = __builtin_amdgcn_mfma_f32_32x32x16_bf16(pa0, PK(l0, h0), od, 0, 0, 0);
  od = __builtin_amdgcn_mfma_f32_32x32x16_bf16(pa1, PK(l1, h1), od, 0, 0, 0);
  od = __builtin_amdgcn_mfma_f32_32x32x16_bf16(pa2, PK(l2, h2), od, 0, 0, 0);
  od = __builtin_amdgcn_mfma_f32_32x32x16_bf16(pa3, PK(l3, h3), od, 0, 0, 0);
#undef PK
}
__device__ __forceinline__ void pv_d0(f32x16* o, int vb, bf16x8 pa0, bf16x8 pa1, bf16x8 pa2, bf16x8 pa3) {
  pv_one<0>(o[0], vb, pa0, pa1, pa2, pa3); pv_one<1>(o[1], vb, pa0, pa1, pa2, pa3); pv_one<2>(o[2], vb, pa0, pa1, pa2, pa3); pv_one<3>(o[3], vb, pa0, pa1, pa2, pa3);
}

template <class P>
__device__ __forceinline__ void attn_unit(LAS char* lds, const P& pol) {
  constexpr int NT = P::NT; constexpr bool NAT = P::NAT;
  int tid = threadIdx.x; asm volatile("" : "+v"(tid));
  const int wid = tid >> 6, lane = tid & 63, r32 = lane & 31, hi = lane >> 5;
  LAS char* V_lds = lds; LAS char* K_lds = lds + 2 * SHM_V;
  LAS float* ws = (LAS float*)(lds + WS_OFF) + wid * 64; LAS float* li_l = ws; LAS float* al_l = ws + 32;
  float m_reg = NEG, l_reg = 0; f32x16 o[4] = {}; bf16x8 qr[8];
  { const bf16* Qw = pol.qptr(wid, r32) + hi * 8;
#pragma unroll
    for (int d0 = 0; d0 < 8; ++d0) qr[d0] = ld8(Qw + d0 * 16); }
  const int sr = tid >> 4, sc = (tid & 15) * 8, vst0 = v_st(sr, sc), vst1 = v_st(32 + sr, sc);
  const int vb0 = (int)(unsigned)(uintptr_t)V_lds + v_rd_base(lane);
  struct { bf16x8 vs0, vs1, ks0, ks1; } sr_[2];
#define SLOAD(i, j) do { const int _k0 = (j) * KVBLK + sr; sr_[i].vs0 = ld8(pol.vptr(_k0) + sc); sr_[i].vs1 = ld8(pol.vptr(_k0 + 32) + sc); \
    sr_[i].ks0 = ld8(pol.kptr(_k0) + sc); sr_[i].ks1 = ld8(pol.kptr(_k0 + 32) + sc); } while (0)
#define SWRITE(b, i) do { *(LAS bf16x8*)(V_lds + (b) * SHM_V + vst0) = sr_[i].vs0;          \
    *(LAS bf16x8*)(V_lds + (b) * SHM_V + vst1) = sr_[i].vs1; const int kc = sc * 2;               \
    *(LAS bf16x8*)(K_lds + (b) * SHM_K + KSWZ(sr, kc)) = sr_[i].ks0;                       \
    *(LAS bf16x8*)(K_lds + (b) * SHM_K + KSWZ(32 + sr, kc)) = sr_[i].ks1; } while (0)
#define SWAIT() asm volatile("s_waitcnt vmcnt(4)" ::: "memory")
#define RESC(a) do { if (__any((a) < 1.f)) { if (hi == 0) al_l[r32] = (a); asm volatile("s_waitcnt lgkmcnt(0)" ::: "memory"); \
    _Pragma("unroll") for (int d = 0; d < 4; ++d) _Pragma("unroll") for (int r = 0; r < 16; ++r) o[d][r] *= al_l[crow(r, hi)]; } } while (0)
  f32x16 pA0, pA1, pB0, pB1; float mnA, mnB, alA, alB; bf16x8 pa0, pa1, pa2, pa3;
  constexpr int SE = 0, SO = 1;
  SLOAD(SE, 0); asm volatile("s_waitcnt vmcnt(0)" ::: "memory"); SWRITE(0, SE); __syncthreads();
  qkt(pA0, pA1, K_lds, qr, r32, hi); pol.apply(pA0, pA1, 0, wid, r32, hi); partialSM<NAT>(pA0, pA1, m_reg, mnA, alA);
  SLOAD(SO, 1); if (2 < NT) SLOAD(SE, 2);
  SWAIT(); SWRITE(1, SO); __syncthreads();
  for (int j = 1; j + 1 < NT; j += 2) {
    SBAR(); qkt(pB0, pB1, K_lds + SHM_K, qr, r32, hi); pol.apply(pB0, pB1, j, wid, r32, hi);
    finishSM(pA0, pA1, alA, l_reg, pa0, pa1, pa2, pa3); SBAR();
    SLOAD(SO, j + 2); SBAR();
    pv_d0(o, vb0, pa0, pa1, pa2, pa3); partialSM<NAT>(pB0, pB1, m_reg, mnB, alB);
    __syncthreads(); SWAIT(); SWRITE(0, SE);
    RESC(alB); __syncthreads();
    SBAR(); qkt(pA0, pA1, K_lds, qr, r32, hi); pol.apply(pA0, pA1, j + 1, wid, r32, hi);
    finishSM(pB0, pB1, alB, l_reg, pa0, pa1, pa2, pa3); SBAR();
    if (j + 3 < NT) SLOAD(SE, j + 3); SBAR();
    pv_d0(o, vb0 + SHM_V, pa0, pa1, pa2, pa3); partialSM<NAT>(pA0, pA1, m_reg, mnA, alA);
    __syncthreads(); SWAIT(); SWRITE(1, SO);
    RESC(alA); __syncthreads();
  }
  SBAR(); qkt(pB0, pB1, K_lds + SHM_K, qr, r32, hi); pol.apply(pB0, pB1, NT - 1, wid, r32, hi);
  finishSM(pA0, pA1, alA, l_reg, pa0, pa1, pa2, pa3); SBAR();
  pv_d0(o, vb0, pa0, pa1, pa2, pa3); partialSM<NAT>(pB0, pB1, m_reg, mnB, alB);
  __syncthreads(); RESC(alB);
  finishSM(pB0, pB1, alB, l_reg, pa0, pa1, pa2, pa3); SBAR();
  pv_d0(o, vb0 + SHM_V, pa0, pa1, pa2, pa3);
  { const float f = pol.finish(wid, r32, hi, m_reg, l_reg); if (hi == 0) li_l[r32] = f; }
  __syncthreads();
  float rli[16];
#pragma unroll
  for (int r = 0; r < 16; ++r) rli[r] = li_l[crow(r, hi)];
  LAS char* stg = lds + wid * 8192;
#pragma unroll
  for (int r = 0; r < 16; ++r) { const int orow = crow(r, hi);
#pragma unroll
    for (int d0 = 0; d0 < 4; ++d0) *(LAS unsigned short*)(stg + orow * 256 + (d0 * 32 + r32) * 2) = (unsigned short)f2bf(o[d0][r] * rli[r]); }
  asm volatile("s_waitcnt lgkmcnt(0)" ::: "memory");
#pragma unroll
  for (int i = 0; i < 8; ++i) { const int c = i * 64 + lane, row = c >> 4, c16 = c & 15;
    const u32x4 v = *(const LAS u32x4*)(stg + row * 256 + c16 * 16);
    *(u32x4*)(pol.optr(wid, row) + c16 * 8) = v; }
  __syncthreads();
#undef SLOAD
#undef SWRITE
#undef SWAIT
#undef RESC
}

template <int D0> __device__ __forceinline__ void pv_half(f32x16& od, int vb, bf16x8 pa, bf16x8 pb, bool second) {
  if (!second) {
    const s16x4 l0 = tr_read<v_rd_off(D0, 0, 0)>(vb), h0 = tr_read<v_rd_off(D0, 0, 1)>(vb), l1 = tr_read<v_rd_off(D0, 1, 0)>(vb), h1 = tr_read<v_rd_off(D0, 1, 1)>(vb);
    asm volatile("s_waitcnt lgkmcnt(0)" ::: "memory"); SBAR();
    od = __builtin_amdgcn_mfma_f32_32x32x16_bf16(pa, ((bf16x8){l0[0], l0[1], l0[2], l0[3], h0[0], h0[1], h0[2], h0[3]}), od, 0, 0, 0);
    od = __builtin_amdgcn_mfma_f32_32x32x16_bf16(pb, ((bf16x8){l1[0], l1[1], l1[2], l1[3], h1[0], h1[1], h1[2], h1[3]}), od, 0, 0, 0);
  } else {
    const s16x4 l2 = tr_read<v_rd_off(D0, 2, 0)>(vb), h2 = tr_read<v_rd_off(D0, 2, 1)>(vb), l3 = tr_read<v_rd_off(D0, 3, 0)>(vb), h3 = tr_read<v_rd_off(D0, 3, 1)>(vb);
    asm volatile("s_waitcnt lgkmcnt(0)" ::: "memory"); SBAR();
    od = __builtin_amdgcn_mfma_f32_32x32x16_bf16(pa, ((bf16x8){l2[0], l2[1], l2[2], l2[3], h2[0], h2[1], h2[2], h2[3]}), od, 0, 0, 0);
    od = __builtin_amdgcn_mfma_f32_32x32x16_bf16(pb, ((bf16x8){l3[0], l3[1], l3[2], l3[3], h3[0], h3[1], h3[2], h3[3]}), od, 0, 0, 0);
  }
}
__device__ __forceinline__ void qkt_half(f32x16& p, const LAS char* Ks, const bf16x8* qr, int krow, int hi) {
  p = f32x16{};
#pragma unroll
  for (int d0 = 0; d0 < 8; ++d0) { const int cb = (d0 * 16 + hi * 8) * 2;
    bf16x8 b0 = *reinterpret_cast<const LAS bf16x8*>(Ks + KSWZ(krow, cb));
    p = __builtin_amdgcn_mfma_f32_32x32x16_bf16(b0, qr[d0], p, 0, 0, 0); }
}
template <class P>
__device__ __forceinline__ void attn_unit_simple(LAS char* lds, const P& pol) {
  constexpr int NT = P::NT;
  int tid = threadIdx.x; asm volatile("" : "+v"(tid));
  const int wid = tid >> 6, lane = tid & 63, r32 = lane & 31, hi = lane >> 5;
  const int wu = __builtin_amdgcn_readfirstlane(wid);
  LAS char* V_lds = lds; LAS char* K_lds = lds + 2 * SHM_V;
  LAS float* ws = (LAS float*)(lds + WS_OFF) + wid * 64; LAS float* li_l = ws; LAS float* al_l = ws + 32;
  float m_reg = NEG, l_reg = 0; f32x16 o[4] = {}; bf16x8 qr[8];
  { const bf16* Qw = pol.qptr(wid, r32) + hi * 8;
#pragma unroll
    for (int d0 = 0; d0 < 8; ++d0) qr[d0] = ld8(Qw + d0 * 16); }
  const int sr = tid >> 4, sc = (tid & 15) * 8, vst0 = v_st(sr, sc), vst1 = v_st(32 + sr, sc);
  const int vb0 = (int)(unsigned)(uintptr_t)V_lds + v_rd_base(lane);
  bf16x8 vs0, vs1, ks0, ks1;
#define SLOAD1(j) do { const int _k0 = (j) * KVBLK + sr; vs0 = ld8(pol.vptr(_k0) + sc); vs1 = ld8(pol.vptr(_k0 + 32) + sc); \
    ks0 = ld8(pol.kptr(_k0) + sc); ks1 = ld8(pol.kptr(_k0 + 32) + sc); } while (0)
#define SWRITE1(b) do { *(LAS bf16x8*)(V_lds + (b) * SHM_V + vst0) = vs0; *(LAS bf16x8*)(V_lds + (b) * SHM_V + vst1) = vs1; const int kc = sc * 2; \
    *(LAS bf16x8*)(K_lds + (b) * SHM_K + KSWZ(sr, kc)) = ks0; *(LAS bf16x8*)(K_lds + (b) * SHM_K + KSWZ(32 + sr, kc)) = ks1; } while (0)
  SLOAD1(0); asm volatile("s_waitcnt vmcnt(0)" ::: "memory"); SWRITE1(0); __syncthreads();
  for (int j = 0; j < NT; ++j) {
    const int b = j & 1;
    if (j + 1 < NT) SLOAD1(j + 1);
    const bool a0 = pol.active(j, wu, 0), a1 = pol.active(j, wu, 1);
    if (a0 || a1) {
      f32x16 p0, p1; float mn, al; bf16x8 pa0, pa1, pa2, pa3;
      if (a0) qkt_half(p0, K_lds + b * SHM_K, qr, r32, hi); else { _Pragma("unroll") for (int r = 0; r < 16; ++r) p0[r] = 0.f; }
      if (a1) qkt_half(p1, K_lds + b * SHM_K, qr, 32 + r32, hi); else { _Pragma("unroll") for (int r = 0; r < 16; ++r) p1[r] = 0.f; }
      pol.apply(p0, p1, j, wid, r32, hi);
      if (!a0) { _Pragma("unroll") for (int r = 0; r < 16; ++r) p0[r] = NEG; }
      if (!a1) { _Pragma("unroll") for (int r = 0; r < 16; ++r) p1[r] = NEG; }
      partialSM<true>(p0, p1, m_reg, mn, al);
      if (__any(al < 1.f)) { if (hi == 0) al_l[r32] = al; asm volatile("s_waitcnt lgkmcnt(0)" ::: "memory");
#pragma unroll
        for (int d = 0; d < 4; ++d)
#pragma unroll
          for (int r = 0; r < 16; ++r) o[d][r] *= al_l[crow(r, hi)]; }
      finishSM(p0, p1, al, l_reg, pa0, pa1, pa2, pa3); SBAR();
      const int vb = vb0 + b * SHM_V;
      if (a0) { pv_half<0>(o[0], vb, pa0, pa1, false); pv_half<1>(o[1], vb, pa0, pa1, false); pv_half<2>(o[2], vb, pa0, pa1, false); pv_half<3>(o[3], vb, pa0, pa1, false); }
      if (a1) { pv_half<0>(o[0], vb, pa2, pa3, true); pv_half<1>(o[1], vb, pa2, pa3, true); pv_half<2>(o[2], vb, pa2, pa3, true); pv_half<3>(o[3], vb, pa2, pa3, true); }
    }
    if (j + 1 < NT) { asm volatile("s_waitcnt vmcnt(0)" ::: "memory"); SWRITE1(b ^ 1); }
    __syncthreads();
  }
  { const float f = pol.finish(wid, r32, hi, m_reg, l_reg); if (hi == 0) li_l[r32] = f; }
  asm volatile("s_waitcnt lgkmcnt(0)" ::: "memory");
  float rli[16];
#pragma unroll
  for (int r = 0; r < 16; ++r) rli[r] = li_l[crow(r, hi)];
  LAS char* stg = lds + wid * 8192;
#pragma unroll
  for (int r = 0; r < 16; ++r) { const int orow = crow(r, hi);
#pragma unroll
    for (int d0 = 0; d0 < 4; ++d0) *(LAS unsigned short*)(stg + orow * 256 + (d0 * 32 + r32) * 2) = (unsigned short)f2bf(o[d0][r] * rli[r]); }
  asm volatile("s_waitcnt lgkmcnt(0)" ::: "memory");
#pragma unroll
  for (int i = 0; i < 8; ++i) { const int c = i * 64 + lane, row = c >> 4, c16 = c & 15;
    const u32x4 v = *(const LAS u32x4*)(stg + row * 256 + c16 * 16);
    if constexpr (P::NT_OUT) __builtin_nontemporal_store(v, (u32x4*)(pol.optr(wid, row) + c16 * 8)); else *(u32x4*)(pol.optr(wid, row) + c16 * 8) = v; }
  __syncthreads();
#undef SLOAD1
#undef SWRITE1
}

struct PolDense {
  static constexpr int NT = SEQ / KVBLK; static constexpr bool NAT = false;
  const bf16* q; const bf16* k; const bf16* v; bf16* o; int qp, kp, op;
  __device__ __forceinline__ const bf16* qptr(int w, int r32) const { return q + (size_t)(w * 32 + r32) * qp; }
  __device__ __forceinline__ const bf16* kptr(int kk) const { return k + (size_t)kk * kp; }
  __device__ __forceinline__ const bf16* vptr(int kk) const { return v + (size_t)kk * kp; }
  __device__ __forceinline__ void apply(f32x16&, f32x16&, int, int, int, int) const {}
  __device__ __forceinline__ float finish(int, int, int, float, float l) const { return __builtin_amdgcn_rcpf(l); }
  __device__ __forceinline__ bf16* optr(int w, int row) const { return o + (size_t)(w * 32 + row) * op; }
};
template <int NT_, bool IS_A> struct PolBand {
  static constexpr int NT = NT_; static constexpr bool NAT = true, NT_OUT = !IS_A;
  const bf16* q; const bf16* k; const bf16* v; bf16* o; int qp, kp, op;
  int pos0, lim, dil, rho;
  const LAS float* tab; float sink; float* lse;
  __device__ __forceinline__ const bf16* qptr(int w, int r32) const { return q + (size_t)((w * 32 + r32) * dil) * qp; }
  __device__ __forceinline__ int ktok(int kk) const { int p = pos0 + kk; p = p < 0 ? 0 : (p >= lim ? lim - 1 : p); return rho + dil * p; }
  __device__ __forceinline__ const bf16* kptr(int kk) const { return k + (size_t)ktok(kk) * kp; }
  __device__ __forceinline__ const bf16* vptr(int kk) const { return v + (size_t)ktok(kk) * kp; }
  __device__ __forceinline__ void apply(f32x16& p0, f32x16& p1, int j, int w, int r32, int hi) const {
    const int ql = w * 32 + r32; const LAS float* tb = tab + (j * 64 - ql + 255 + 4 * hi);
#pragma unroll
    for (int r = 0; r < 16; ++r) { const int c = (r & 3) + 8 * (r >> 2); p0[r] = fmaf(p0[r], SCALE, tb[c]); p1[r] = fmaf(p1[r], SCALE, tb[c + 32]); }
    const int t0 = pos0 + j * 64;
    if (t0 < 0 || t0 + 63 >= lim) {
#pragma unroll
      for (int r = 0; r < 16; ++r) { const int kp0 = t0 + crow(r, hi); if ((unsigned)kp0 >= (unsigned)lim) p0[r] = NEG; if ((unsigned)(kp0 + 32) >= (unsigned)lim) p1[r] = NEG; }
    }
  }
  __device__ __forceinline__ bool active(int j, int w, int h) const {
    constexpr int W = (NT_ * 64 - 256) / 2;
    const int k0 = 64 * j + 32 * h, q0 = 32 * w;
    return (k0 <= 2 * W + q0 + 31) && (k0 + 31 >= q0) && (pos0 + k0 + 31 >= 0) && (pos0 + k0 < lim);
  }
  __device__ __forceinline__ float finish(int w, int r32, int hi, float m, float l) const {
    const float lsev = m + __logf(l);
    if constexpr (IS_A) { const float keep = __builtin_amdgcn_rcpf(1.0f + __expf(sink - lsev)); return keep * __builtin_amdgcn_rcpf(l); }
    else { if (hi == 0) lse[w * 32 + r32] = lsev; return __builtin_amdgcn_rcpf(l); }
  }
  __device__ __forceinline__ bf16* optr(int w, int row) const { return o + (size_t)((w * 32 + row) * dil) * op; }
};
struct PolNA {
  static constexpr int NT = 8; static constexpr bool NAT = true, NT_OUT = false;
  const bf16* q; const bf16* k; const bf16* v; bf16* o;
  int drow0;
  const LAS float* tab;
  __device__ __forceinline__ const bf16* qptr(int w, int r32) const { return q + (size_t)((w >> 1) * 16 + (r32 & 15)) * CD_IN + (2 * (w & 1) + (r32 >> 4)) * HD; }
  __device__ __forceinline__ const bf16* kptr(int kk) const { return k + (size_t)kk * CD_IN; }
  __device__ __forceinline__ const bf16* vptr(int kk) const { return v + (size_t)kk * CD_IN; }
  __device__ __forceinline__ void apply(f32x16& p0, f32x16& p1, int j, int w, int r32, int hi) const {
    const int qc = (w >> 1) * 16 + (r32 & 15), g = 2 * (w & 1) + (r32 >> 4);
    int cs = qc - 8; cs = cs < 0 ? 0 : (cs > 48 ? 48 : cs);
    const LAS float* tb = tab + (g * 15 + drow0 + j) * 31;
#pragma unroll
    for (int r = 0; r < 16; ++r) { const int kc = crow(r, hi);
      { int dc = kc - qc + 15; dc = dc < 0 ? 0 : (dc > 30 ? 30 : dc); const float b = tb[dc]; p0[r] = ((unsigned)(kc - cs) < 16u) ? fmaf(p0[r], SCALE, b) : NEG; }
      { int dc = kc + 32 - qc + 15; dc = dc < 0 ? 0 : (dc > 30 ? 30 : dc); const float b = tb[dc]; p1[r] = ((unsigned)(kc + 32 - cs) < 16u) ? fmaf(p1[r], SCALE, b) : NEG; } }
  }
  __device__ __forceinline__ bool active(int, int w, int h) const { const int jb = w >> 1; return h == 0 ? (jb < 3) : (jb > 0); }
  __device__ __forceinline__ float finish(int, int, int, float, float l) const { return __builtin_amdgcn_rcpf(l); }
  __device__ __forceinline__ bf16* optr(int w, int row) const { return o + (size_t)((w >> 1) * 16 + (row & 15)) * CD_OUT + (2 * (w & 1) + (row >> 4)) * HD; }
};
}

constexpr size_t MiB = 1u << 20;
constexpr size_t WS_CTL = 0, CTL_ZERO_BYTES = 1 * MiB;
constexpr size_t WS_W = 1 * MiB;
constexpr size_t FFN_WIN_B = (size_t)2 * DFF * DM * 2  , FFN_WOUT_B = (size_t)DM * DFF * 2  , FFN_B = FFN_WIN_B + FFN_WOUT_B;
constexpr size_t WS_WFFN = WS_W;
constexpr size_t AB_WIN_B = (size_t)AB_IN * DM * 2, AB_WOUT_B = (size_t)DM * AB_OUT * 2, AB_B = AB_WIN_B + AB_WOUT_B;
constexpr size_t CD_WIN_B = (size_t)CD_IN * DM * 2, CD_WOUT_B = (size_t)DM * CD_OUT * 2, CD_B = CD_WIN_B + CD_WOUT_B;
constexpr size_t WS_WAB = WS_WFFN + 8 * FFN_B, WS_WCD = WS_WAB + 2 * AB_B, WS_WEND = WS_WCD + 2 * CD_B;
constexpr size_t WS_H = WS_WEND;
constexpr size_t H_B = (size_t)MTOK * DM * 2;
constexpr size_t DPART_B = (size_t)MTOK * 512 * 2;
constexpr size_t WS_DLSE = WS_H + 3 * DPART_B;
static_assert(WS_DLSE + (size_t)3 * 4 * MTOK * 4 <= WS_H + H_B, "D partials fit in H");
constexpr size_t WS_BIG = WS_H + H_B;
constexpr size_t WS_QKV = WS_BIG, WS_O = WS_BIG + (size_t)MTOK * CD_IN * 2;
constexpr size_t WS_DELTA = WS_H;
constexpr size_t WS_XH = WS_O + (size_t)MTOK * DM * 2;
constexpr size_t WS_END = WS_XH + (size_t)MTOK * DM * 2;
static_assert(WS_BIG + (size_t)MTOK * DFF * 2 <= WS_XH, "ACT fits");
constexpr int CW_BAR = 4096;

constexpr int RING_OFF = 0, RING_BYTES = 131072;
constexpr int LDS_BYTES = 147456;
constexpr int LDSCTL_OFF = LDS_BYTES - 512, MISC_OFF = LDSCTL_OFF + 320;
static_assert(att::ATT_LDS <= RING_BYTES, "attention LDS inside the ring region");
constexpr int NWAVES = 8;

#define XB_TMO      128
#define XB_XCNT(j)  (256  + 64 * (j))
#define XB_XSUB(j)  (1280 + 64 * (j))
#define XB_XGEN(j)  (2304 + 64 * (j))
#define XB_TOP      3328
#define XB_TOPGEN   3392
#define XCD_BAR_WORDS 3456
#define XB_SPIN_CAP (1u << 22)

__device__ __forceinline__ unsigned xb_ld(unsigned* p)              { return __hip_atomic_load(p, __ATOMIC_RELAXED, __HIP_MEMORY_SCOPE_AGENT); }
__device__ __forceinline__ unsigned xb_add(unsigned* p, unsigned v) { return __hip_atomic_fetch_add(p, v, __ATOMIC_RELAXED, __HIP_MEMORY_SCOPE_AGENT); }
__device__ __forceinline__ unsigned xb_xcc_id() { return (unsigned)__builtin_amdgcn_s_getreg((3 << 11) | 20) & 0xFu; }
#define XB_SPIN(cond, bar) do { unsigned _sp = 0; while (cond) { __builtin_amdgcn_s_sleep(1); \
    if ((++_sp & 255u) == 0u) { if (xb_ld(&(bar)[XB_TMO])) break; if (_sp > XB_SPIN_CAP) { atomicAdd(&(bar)[XB_TMO], 1u); break; } } } } while (0)

struct XcdBarrier { unsigned* bar; unsigned x; volatile LAS unsigned* st; };

__device__ __forceinline__ XcdBarrier xcd_barrier_post(unsigned* bar, volatile LAS unsigned* st) {
    XcdBarrier b; b.bar = bar; b.x = xb_xcc_id(); b.st = st;
    if (threadIdx.x == 0) (void)xb_add(&bar[XB_XCNT(b.x)], 1u);
    return b;
}
__device__ __forceinline__ void xcd_barrier_complete(unsigned* bar, unsigned x, unsigned& nloc, unsigned& nx) {
    const unsigned G = gridDim.x * gridDim.y * gridDim.z;
    unsigned sum, cnt, mine, sp = 0u;
    for (;;) {
        sum = 0u; cnt = 0u; mine = 0u;
#pragma unroll
        for (unsigned j = 0; j < 16; ++j) { const unsigned c = xb_ld(&bar[XB_XCNT(j)]); sum += c; cnt += (c > 0u) ? 1u : 0u; mine = (j == x) ? c : mine; }
        if (sum == G) break;
        __builtin_amdgcn_s_sleep(1);
        if ((++sp & 255u) == 0u) { if (xb_ld(&bar[XB_TMO])) break; if (sp > XB_SPIN_CAP) { atomicAdd(&bar[XB_TMO], 1u); break; } }
    }
    nloc = mine > 0u ? mine : 1u; nx = cnt > 0u ? cnt : 1u;
}
__device__ __forceinline__ void xcd_barrier(const XcdBarrier& b) {
    asm volatile("s_waitcnt vmcnt(0)" ::: "memory");
    __syncthreads();
    if (threadIdx.x == 0) {
        unsigned* bar = b.bar;
        __builtin_amdgcn_s_waitcnt(0);
        unsigned nloc = b.st[0], nx = b.st[1];
        if (nloc == 0u) { xcd_barrier_complete(bar, b.x, nloc, nx); b.st[0] = nloc; b.st[1] = nx; }
        const unsigned old = xb_add(&bar[XB_XSUB(b.x)], 1u);
        const unsigned gen = old / nloc;
        if (old + 1u == (gen + 1u) * nloc) {
            __builtin_amdgcn_fence(__ATOMIC_RELEASE, "agent");
            asm volatile("s_waitcnt vmcnt(0)" ::: "memory");
            const unsigned og = xb_add(&bar[XB_TOP], 1u);
            const unsigned tg = og / nx;
            if (og + 1u == (tg + 1u) * nx) xb_add(&bar[XB_TOPGEN], 1u);
            else XB_SPIN(xb_ld(&bar[XB_TOPGEN]) == tg, bar);
            __builtin_amdgcn_fence(__ATOMIC_ACQUIRE, "agent");
            xb_add(&bar[XB_XGEN(b.x)], 1u);
            asm volatile("s_waitcnt vmcnt(0)" ::: "memory");
        } else {
            XB_SPIN(xb_ld(&bar[XB_XGEN(b.x)]) == gen, bar);
            __builtin_amdgcn_fence(__ATOMIC_ACQUIRE, "agent");
            asm volatile("s_waitcnt vmcnt(0)" ::: "memory");
        }
    }
    __syncthreads();
}

struct Args {
    const float* in[19]; float* out; unsigned char* ws; int ph_lo, ph_hi;
};
struct Frame {
    LAS unsigned char* lds; volatile LAS unsigned* MISC;
    int vcu, G;
    float* out; unsigned char* ws;
};
#define PHASE_TID() int tid_ = threadIdx.x; asm volatile("" : "+v"(tid_)); const int lane_ = tid_ & 63, wave_ = __builtin_amdgcn_readfirstlane(tid_ >> 6); (void)lane_; (void)wave_
__device__ __forceinline__ float wave_sum(float v) {
#pragma unroll
    for (int o = 1; o < 64; o <<= 1) v += __shfl_xor(v, o);
    return v;
}

template <int MODE>
__device__ __forceinline__ void convert_item64(const float* W, int K, int N, bf16* WT, LAS float* scr, int item, int lane) {
    const int nblk = N / 64, kb = item / nblk, nb = item % nblk, k0 = 64 * kb, n0 = 64 * nb;
    const int kr = lane >> 4, nc = 4 * (lane & 15);
    f32x4 v[16];
#pragma unroll
    for (int i = 0; i < 16; ++i) v[i] = __builtin_nontemporal_load((const f32x4*)(W + (size_t)(k0 + 4 * i + kr) * N + n0 + nc));
#pragma unroll
    for (int i = 0; i < 16; ++i) { LAS float* d = scr + (4 * i + kr) * 65 + nc; d[0] = v[i].x; d[1] = v[i].y; d[2] = v[i].z; d[3] = v[i].w; }
    LDS_WAIT(); asm volatile("" ::: "memory");
    int r0 = n0;
    if (MODE == 1) { const int up = n0 >= DFF, c = up ? n0 - DFF : n0; r0 = 256 * (c >> 7) + (up ? 128 : 0) + (c & 127); }
    const int c8 = lane & 7;
#pragma unroll
    for (int j = 0; j < 8; ++j) { const int n = (lane >> 3) + 8 * j; const LAS float* p = scr + (8 * c8) * 65 + n;
        v4u o; o.x = pk2(p[0 * 65], p[1 * 65]); o.y = pk2(p[2 * 65], p[3 * 65]); o.z = pk2(p[4 * 65], p[5 * 65]); o.w = pk2(p[6 * 65], p[7 * 65]);
        *(GAS v4u*)(WT + (size_t)(r0 + n) * K + k0 + 8 * c8) = o; }
    LDS_WAIT(); asm volatile("" ::: "memory");
}
template <int MODE>
__device__ __forceinline__ void convert_matrix(Frame& F, const float* W, int K, int N, bf16* WT, int cu, int ncu) {
    PHASE_TID();
    LAS float* scr = (LAS float*)(F.lds + wave_ * 16640);
    const int gw = cu * NWAVES + wave_, NGW = ncu * NWAVES, nitems = (K / 64) * (N / 64);
    for (int it = gw; it < nitems; it += NGW) convert_item64<MODE>(W, K, N, WT, scr, it, lane_);
}

template <bool FIRST>
__device__ __forceinline__ void norm_phase(Frame& F, const float* xp, const float* xs, const float* gain, bf16* H, const bf16* Dl, unsigned short* XH) {
    PHASE_TID();
    const int gw = F.vcu * NWAVES + wave_, NGW = F.G * NWAVES;
    f32x4 g[8];
#pragma unroll
    for (int j = 0; j < 8; ++j) g[j] = *(const f32x4*)(gain + 4 * lane_ + 256 * j);
    for (int m = gw; m < MTOK; m += NGW) {
        f32x4 v[8]; float s = 0.f;
        if (FIRST) {
            const float* src = m < MPROMPT ? xp + (size_t)m * DM : xs + (size_t)(m - MPROMPT) * DM;
#pragma unroll
            for (int j = 0; j < 8; ++j) v[j] = __builtin_nontemporal_load((const f32x4*)(src + 4 * lane_ + 256 * j));
        } else {
#pragma unroll
            for (int j = 0; j < 8; ++j) { const v2u xh = __builtin_nontemporal_load((const v2u*)(XH + (size_t)m * DM + 4 * lane_ + 256 * j)); const v2u d = __builtin_nontemporal_load((const v2u*)(Dl + (size_t)m * DM + 4 * lane_ + 256 * j));
                v[j].x = hlo(xh.x) + bflo(d.x); v[j].y = hhi(xh.x) + bfhi(d.x); v[j].z = hlo(xh.y) + bflo(d.y); v[j].w = hhi(xh.y) + bfhi(d.y); }
        }
#pragma unroll
        for (int j = 0; j < 8; ++j) s += (v[j].x * v[j].x + v[j].y * v[j].y) + (v[j].z * v[j].z + v[j].w * v[j].w);
        const float rs = rsqrtf(wave_sum(s) * (1.f / DM) + NORM_EPS);
#pragma unroll
        for (int j = 0; j < 8; ++j) { v2u w; w.x = pk2h(v[j].x, v[j].y); w.y = pk2h(v[j].z, v[j].w); __builtin_nontemporal_store(w, (v2u*)(XH + (size_t)m * DM + 4 * lane_ + 256 * j)); }
#pragma unroll
        for (int j = 0; j < 8; ++j) { v2u w; w.x = pk2(v[j].x * rs * g[j].x, v[j].y * rs * g[j].y); w.y = pk2(v[j].z * rs * g[j].z, v[j].w * rs * g[j].w);
            *(v2u*)(H + (size_t)m * DM + 4 * lane_ + 256 * j) = w; }
    }
}
__device__ __forceinline__ void final_norm_phase(Frame& F, const float* gain, float oscale, const bf16* Dl, const unsigned short* XH) {
    PHASE_TID();
    const int gw = F.vcu * NWAVES + wave_, NGW = F.G * NWAVES;
    f32x4 g[8];
#pragma unroll
    for (int j = 0; j < 8; ++j) g[j] = *(const f32x4*)(gain + 4 * lane_ + 256 * j);
    for (int m = gw; m < MTOK; m += NGW) {
        float* row = F.out + (size_t)m * DM;
        f32x4 v[8]; float s = 0.f;
#pragma unroll
        for (int j = 0; j < 8; ++j) { const v2u xh = __builtin_nontemporal_load((const v2u*)(XH + (size_t)m * DM + 4 * lane_ + 256 * j)); const v2u d = __builtin_nontemporal_load((const v2u*)(Dl + (size_t)m * DM + 4 * lane_ + 256 * j));
            v[j].x = hlo(xh.x) + bflo(d.x); v[j].y = hhi(xh.x) + bfhi(d.x); v[j].z = hlo(xh.y) + bflo(d.y); v[j].w = hhi(xh.y) + bfhi(d.y);
            s += (v[j].x * v[j].x + v[j].y * v[j].y) + (v[j].z * v[j].z + v[j].w * v[j].w); }
        const float rs = rsqrtf(wave_sum(s) * (1.f / DM) + NORM_EPS) * oscale;
#pragma unroll
        for (int j = 0; j < 8; ++j) __builtin_nontemporal_store(v[j] * rs * g[j], (f32x4*)(row + 4 * lane_ + 256 * j));
    }
}

__device__ __forceinline__ void prep_phase(Frame& F, bf16* QKV, const float* qg, const float* kg) {
    PHASE_TID();
    const int gw = F.vcu * NWAVES + wave_, NGW = F.G * NWAVES;
    const int l16 = lane_ & 15, vsub = lane_ >> 4;
    float gq[8], gk[8], om[4];
#pragma unroll
    for (int e = 0; e < 8; ++e) { gq[e] = qg[l16 * 8 + e]; gk[e] = kg[l16 * 8 + e]; }
#pragma unroll
    for (int e = 0; e < 4; ++e) { const int f = (l16 * 4 + e) & 31; om[e] = exp2f(-(float)f * 0.41524101186092029f) * 0.15915494309189535f; }
    for (int m = gw; m < MTOK; m += NGW) {
        const int t = m & (SEQ - 1); const float pos = (float)((l16 < 8) ? (t >> 6) : (t & 63));
        float cs[4], sn[4];
#pragma unroll
        for (int e = 0; e < 4; ++e) { const float rev = pos * om[e]; cs[e] = __builtin_amdgcn_cosf(rev); sn[e] = __builtin_amdgcn_sinf(rev); }
        bf16* row = QKV + (size_t)m * AB_IN + 1536;
#pragma unroll
        for (int it = 0; it < 3; ++it) {
            const int vi = it * 4 + vsub;
            if (vi < 10) {
                v4u w = *(const v4u*)(row + vi * 128 + l16 * 8);
                float x[8] = {bflo(w.x), bfhi(w.x), bflo(w.y), bfhi(w.y), bflo(w.z), bfhi(w.z), bflo(w.w), bfhi(w.w)};
                float s = 0.f;
#pragma unroll
                for (int e = 0; e < 8; ++e) s += x[e] * x[e];
                s += __shfl_xor(s, 1); s += __shfl_xor(s, 2); s += __shfl_xor(s, 4); s += __shfl_xor(s, 8);
                const float rs = rsqrtf(s * (1.f / 128.f) + NORM_EPS);
#pragma unroll
                for (int e = 0; e < 8; ++e) x[e] = x[e] * rs * (vi < 8 ? gq[e] : gk[e]);
                float y[8];
#pragma unroll
                for (int e = 0; e < 4; ++e) { y[2 * e] = x[2 * e] * cs[e] - x[2 * e + 1] * sn[e]; y[2 * e + 1] = x[2 * e] * sn[e] + x[2 * e + 1] * cs[e]; }
                v4u o; o.x = pk2(y[0], y[1]); o.y = pk2(y[2], y[3]); o.z = pk2(y[4], y[5]); o.w = pk2(y[6], y[7]);
                *(v4u*)(row + vi * 128 + l16 * 8) = o;
            }
        }
    }
}

__device__ __forceinline__ void comb_phase(Frame& F, const bf16* part, const float* lse, bf16* O) {
    PHASE_TID();
    const int gw = F.vcu * NWAVES + wave_, NGW = F.G * NWAVES;
    const int slot = lane_ >> 4, d8 = (lane_ & 15) * 8;
    for (int m = gw; m < MTOK; m += NGW) {
        const int seq = m >> 12, t = m & (SEQ - 1);
        float ls[3];
#pragma unroll
        for (int g = 0; g < 3; ++g) { const int sh = 2 * g, dil = 1 << sh, lsub = SEQ >> sh; const int rho = t & (dil - 1), u = t >> sh;
            ls[g] = lse[((size_t)(g * 4 + slot) * NSEQ + seq) * SEQ + rho * lsub + u]; }
        const float mx = fmaxf(ls[0], fmaxf(ls[1], ls[2]));
        float w[3]; float sum = 0.f;
#pragma unroll
        for (int g = 0; g < 3; ++g) { w[g] = __expf(ls[g] - mx); sum += w[g]; }
        const float inv = 1.f / sum;
        float acc[8] = {0, 0, 0, 0, 0, 0, 0, 0};
#pragma unroll
        for (int g = 0; g < 3; ++g) { const v4u p = __builtin_nontemporal_load((const v4u*)(part + (size_t)g * MTOK * 512 + (size_t)m * 512 + slot * 128 + d8)); const float wg = w[g] * inv;
            acc[0] += wg * bflo(p.x); acc[1] += wg * bfhi(p.x); acc[2] += wg * bflo(p.y); acc[3] += wg * bfhi(p.y);
            acc[4] += wg * bflo(p.z); acc[5] += wg * bfhi(p.z); acc[6] += wg * bflo(p.w); acc[7] += wg * bfhi(p.w); }
        v4u o; o.x = pk2(acc[0], acc[1]); o.y = pk2(acc[2], acc[3]); o.z = pk2(acc[4], acc[5]); o.w = pk2(acc[6], acc[7]);
        *(v4u*)(O + (size_t)m * CD_OUT + 1024 + slot * 128 + d8) = o;
    }
}

__device__ __forceinline__ int t5_bucket(int rel) {
    const int n = rel < 0 ? -rel : rel;
    int b;
    if (n < 8) b = n; else { b = 5 + (31 - __builtin_clz((unsigned)n)); b = b > 15 ? 15 : b; }
    return b + (rel > 0 ? 16 : 0);
}

__device__ __forceinline__ const void* karg_ptr(int byteoff) {
    asm volatile("" : "+s"(byteoff));
    const __attribute__((address_space(4))) char* ka = (const __attribute__((address_space(4))) char*)__builtin_amdgcn_kernarg_segment_ptr();
    return *(const void* const __attribute__((address_space(4)))*)(ka + byteoff);
}

#ifndef CHECK_BUILD
#define CHECK_BUILD 0
#endif
#if CHECK_BUILD
namespace chk {
constexpr int NS = 64;
constexpr int CW_ERR = 8192;
constexpr int CW_EXP = 16384;
__device__ __forceinline__ void sample(int i, int& seq, int& t, int& h) {
    const int sp[16] = {0, 1, 63, 64, 65, 127, 128, 129, 255, 256, 2047, 2048, 4031, 4032, 4094, 4095};
    seq = i % NSEQ; h = (i * 3 + (i >> 3)) & 7; t = i < 16 ? sp[i] : (i * 977 + 131) & 4095;
}
__device__ __forceinline__ float bfv(const bf16* p, int i) { return __builtin_bit_cast(float, (unsigned)p[i] << 16); }
__device__ __forceinline__ float dot128(const bf16* a, const bf16* b) { float s = 0.f; for (int d = 0; d < 128; ++d) s += bfv(a, d) * bfv(b, d); return s; }
__device__ __forceinline__ float wmax(float v) { for (int o = 1; o < 64; o <<= 1) v = fmaxf(v, __shfl_xor(v, o)); return v; }
__device__ __forceinline__ float wsum(float v) { for (int o = 1; o < 64; o <<= 1) v += __shfl_xor(v, o); return v; }
__device__ __forceinline__ void report(unsigned* ctl, float err, int lane) { err = wmax(err); if (lane == 0) atomicMax(ctl + CW_ERR, __float_as_uint(err)); }
__device__ __forceinline__ float softmax_lds(LAS float* sc, int n, int lane) {
    float m = -3e38f; for (int k = lane; k < n; k += 64) m = fmaxf(m, sc[k]); m = wmax(m);
    float l = 0.f; for (int k = lane; k < n; k += 64) { const float p = __expf(sc[k] - m); sc[k] = p; l += p; } l = wsum(l);
    for (int k = lane; k < n; k += 64) sc[k] = sc[k] / l;
    LDS_WAIT(); return m + __logf(l);
}
__device__ __forceinline__ void check_A(const bf16* QKV, const bf16* O, const float* t5, const float* sink, unsigned* ctl, LAS float* sc, int gw, int lane) {
    if (gw >= NS) return; int seq, t, h; sample(gw, seq, t, h); const int kv = h >> 2;
    const bf16* base = QKV + (size_t)seq * SEQ * AB_IN; const bf16* q = base + (size_t)t * AB_IN + h * HD;
    for (int k = lane; k < 257; k += 64) { const int rel = k - 128, kp = t + rel; float v = -1e30f;
        if (kp >= 0 && kp < SEQ) v = dot128(q, base + (size_t)kp * AB_IN + 1024 + kv * HD) * 0.088388347648318440f + t5[t5_bucket(rel) * 20 + h];
        sc[k] = v; }
    LDS_WAIT();
    const float lse = softmax_lds(sc, 257, lane); const float keep = 1.f / (1.f + __expf(-(lse - sink[h])));
    float err = 0.f, mag = 1e-20f, o2[2];
    for (int e = 0; e < 2; ++e) { const int d = lane + 64 * e; float a = 0.f;
        for (int k = 0; k < 257; ++k) { const int kp = t + k - 128; if (kp >= 0 && kp < SEQ) a += sc[k] * bfv(base + (size_t)kp * AB_IN + 1280 + kv * HD, d); }
        o2[e] = a * keep; mag = fmaxf(mag, fabsf(o2[e])); }
    mag = wmax(mag);
    for (int e = 0; e < 2; ++e) { const float got = bfv(O + ((size_t)seq * SEQ + t) * AB_OUT + h * HD, lane + 64 * e); err = fmaxf(err, fabsf(got - o2[e]) / mag); }
    report(ctl, err, lane);
}
__device__ __forceinline__ void prep_ref(const bf16* raw, const float* gain, int t, float* out  ) {
    float ss = 0.f; for (int d = 0; d < 128; ++d) { const float x = bfv(raw, d); ss += x * x; }
    const float rs = 1.f / sqrtf(ss / 128.f + 1e-6f); const float row = (float)(t / 64), col = (float)(t % 64);
    for (int i = 0; i < 64; ++i) { const int f = i % 32; const float om = powf(10000.f, -((float)f * 2.0f / 64.f)); const float ang = (i < 32 ? row : col) * om;
        const float c = cosf(ang), sn = sinf(ang); const float x0 = bfv(raw, 2 * i) * rs * gain[2 * i], x1 = bfv(raw, 2 * i + 1) * rs * gain[2 * i + 1];
        out[2 * i] = x0 * c - x1 * sn; out[2 * i + 1] = x0 * sn + x1 * c; }
}
__device__ __forceinline__ void expect_B(const bf16* QKV, const float* qg, const float* kg, unsigned* ctl, LAS float* sc, LAS float* qs, int gw, int lane) {
    if (gw >= NS) return; int seq, t, h; sample(gw, seq, t, h); const int kv = h >> 2;
    const bf16* base = QKV + (size_t)seq * SEQ * AB_IN;
    if (lane == 0) { const bf16* raw = base + (size_t)t * AB_IN + 1536 + h * HD; float ss = 0.f; for (int d = 0; d < 128; ++d) { const float x = bfv(raw, d); ss += x * x; }
        const float rs = 1.f / sqrtf(ss / 128.f + 1e-6f); const float row = (float)(t / 64), col = (float)(t % 64);
        for (int i = 0; i < 64; ++i) { const int f = i % 32; const float om = powf(10000.f, -((float)f * 2.0f / 64.f)); const float ang = (i < 32 ? row : col) * om;
            const float c = cosf(ang), sn = sinf(ang); const float x0 = bfv(raw, 2 * i) * rs * qg[2 * i], x1 = bfv(raw, 2 * i + 1) * rs * qg[2 * i + 1];
            qs[2 * i] = x0 * c - x1 * sn; qs[2 * i + 1] = x0 * sn + x1 * c; } }
    LDS_WAIT();
    for (int k = lane; k < SEQ; k += 64) { const bf16* raw = base + (size_t)k * AB_IN + 2560 + kv * HD;
        float ss = 0.f; for (int d = 0; d < 128; ++d) { const float x = bfv(raw, d); ss += x * x; }
        const float rs = 1.f / sqrtf(ss / 128.f + 1e-6f); const float row = (float)(k / 64), col = (float)(k % 64); float acc = 0.f;
        for (int i = 0; i < 64; ++i) { const int f = i % 32; const float om = powf(10000.f, -((float)f * 2.0f / 64.f)); const float ang = (i < 32 ? row : col) * om;
            const float c = cosf(ang), sn = sinf(ang); const float x0 = bfv(raw, 2 * i) * rs * kg[2 * i], x1 = bfv(raw, 2 * i + 1) * rs * kg[2 * i + 1];
            acc += qs[2 * i] * (x0 * c - x1 * sn) + qs[2 * i + 1] * (x0 * sn + x1 * c); }
        sc[k] = acc * 0.088388347648318440f; }
    LDS_WAIT();
    (void)softmax_lds(sc, SEQ, lane);
    for (int e = 0; e < 2; ++e) { const int d = lane + 64 * e; float a = 0.f;
        for (int k = 0; k < SEQ; ++k) a += sc[k] * bfv(base + (size_t)k * AB_IN + 2816 + kv * HD, d);
        ((float*)ctl)[CW_EXP + gw * 128 + d] = a; }
}
__device__ __forceinline__ void check_B(const bf16* O, unsigned* ctl, int gw, int lane) {
    if (gw >= NS) return; int seq, t, h; sample(gw, seq, t, h);
    float mag = 1e-20f, err = 0.f;
    for (int e = 0; e < 2; ++e) mag = fmaxf(mag, fabsf(((float*)ctl)[CW_EXP + gw * 128 + lane + 64 * e]));
    mag = wmax(mag);
    for (int e = 0; e < 2; ++e) { const int d = lane + 64 * e; const float got = bfv(O + ((size_t)seq * SEQ + t) * AB_OUT + 1024 + h * HD, d); err = fmaxf(err, fabsf(got - ((float*)ctl)[CW_EXP + gw * 128 + d]) / mag); }
    report(ctl, err, lane);
}
__device__ __forceinline__ void check_C(const bf16* QKV, const bf16* O, const float* rpb, unsigned* ctl, LAS float* sc, int gw, int lane) {
    if (gw >= NS) return; int seq, t, h; sample(gw, seq, t, h); const int kv = h >> 2;
    const bf16* base = QKV + (size_t)seq * SEQ * CD_IN; const bf16* q = base + (size_t)t * CD_IN + h * HD;
    const int r = t / 64, qc = t % 64; int rs = r - 4; rs = rs < 0 ? 0 : (rs > 56 ? 56 : rs); int cs = qc - 8; cs = cs < 0 ? 0 : (cs > 48 ? 48 : cs);
    for (int k = lane; k < 128; k += 64) { const int kr = rs + k / 16, kc = cs + k % 16, kp = kr * 64 + kc;
        sc[k] = dot128(q, base + (size_t)kp * CD_IN + 1024 + kv * HD) * 0.088388347648318440f + rpb[(h * 15 + (kr - r + 7)) * 31 + (kc - qc + 15)]; }
    LDS_WAIT();
    (void)softmax_lds(sc, 128, lane);
    float err = 0.f, mag = 1e-20f, o2[2];
    for (int e = 0; e < 2; ++e) { const int d = lane + 64 * e; float a = 0.f;
        for (int k = 0; k < 128; ++k) { const int kp = (rs + k / 16) * 64 + cs + k % 16; a += sc[k] * bfv(base + (size_t)kp * CD_IN + 1280 + kv * HD, d); }
        o2[e] = a; mag = fmaxf(mag, fabsf(a)); }
    mag = wmax(mag);
    for (int e = 0; e < 2; ++e) { const float got = bfv(O + ((size_t)seq * SEQ + t) * CD_OUT + h * HD, lane + 64 * e); err = fmaxf(err, fabsf(got - o2[e]) / mag); }
    report(ctl, err, lane);
}
__device__ __forceinline__ void check_D(const bf16* QKV, const bf16* O, const float* t5, unsigned* ctl, LAS float* sc, int gw, int lane) {
    if (gw >= NS) return; int seq, t, h; sample(gw, seq, t, h); const int slot = h & 3;
    const bf16* base = QKV + (size_t)seq * SEQ * CD_IN;
    float og[3][2], lse[3];
    for (int g = 0; g < 3; ++g) { const int dil = 1 << (2 * g); const bf16* q = base + (size_t)t * CD_IN + 1536 + g * 512 + slot * HD;
        const int rho = t % dil, u = t / dil, lsub = SEQ / dil;
        for (int k = lane; k < 129; k += 64) { const int rel = k - 64, uk = u + rel; float v = -1e30f;
            if (uk >= 0 && uk < lsub) v = dot128(q, base + (size_t)(uk * dil + rho) * CD_IN + 3072 + slot * HD) * 0.088388347648318440f + t5[t5_bucket(rel * dil) * 20 + 8 + g * 4 + slot];
            sc[k] = v; }
        LDS_WAIT();
        lse[g] = softmax_lds(sc, 129, lane);
        for (int e = 0; e < 2; ++e) { const int d = lane + 64 * e; float a = 0.f;
            for (int k = 0; k < 129; ++k) { const int uk = u + k - 64; if (uk >= 0 && uk < lsub) a += sc[k] * bfv(base + (size_t)(uk * dil + rho) * CD_IN + 3584 + slot * HD, d); }
            og[g][e] = a; }
        LDS_WAIT(); }
    const float mx = fmaxf(lse[0], fmaxf(lse[1], lse[2])); float w[3], ws = 0.f; for (int g = 0; g < 3; ++g) { w[g] = __expf(lse[g] - mx); ws += w[g]; }
    float err = 0.f, mag = 1e-20f, o2[2];
    for (int e = 0; e < 2; ++e) { o2[e] = (w[0] * og[0][e] + w[1] * og[1][e] + w[2] * og[2][e]) / ws; mag = fmaxf(mag, fabsf(o2[e])); }
    mag = wmax(mag);
    for (int e = 0; e < 2; ++e) { const float got = bfv(O + ((size_t)seq * SEQ + t) * CD_OUT + 1024 + slot * HD, lane + 64 * e); err = fmaxf(err, fabsf(got - o2[e]) / mag); }
    report(ctl, err, lane);
}
}
#endif
__global__ void __launch_bounds__(NWAVES * 64, 2) trunk_fwd(Args args) {
    extern __shared__ __attribute__((aligned(16))) unsigned char lds[];
    Frame F;
    F.lds = (LAS unsigned char*)lds;
    F.MISC = (volatile LAS unsigned*)(F.lds + MISC_OFF);
    F.G = gridDim.x; { const int bx = blockIdx.x; F.vcu = (F.G % 8 == 0) ? (bx % 8) * (F.G / 8) + bx / 8 : bx; }
    F.out = args.out; F.ws = args.ws;
    unsigned char* ws = args.ws;
    unsigned* ctl = (unsigned*)(ws + WS_CTL);
    for (int u = threadIdx.x; u < (LDS_BYTES - LDSCTL_OFF) / 4; u += NWAVES * 64) ((LAS unsigned*)(F.lds + LDSCTL_OFF))[u] = 0u;
    __syncthreads();
    XcdBarrier bar = xcd_barrier_post(ctl + CW_BAR, F.MISC + 8);
    const int lo = args.ph_lo, hi = args.ph_hi;
#define IN(k) (lo <= (k) && (k) < hi)
#define SEAM(k) do { if ((k) + 1 < hi) xcd_barrier(bar); } while (0)

#define KARG(i) ((const float*)karg_ptr(8 * (i)))
#define x_prompt KARG(0)
#define x_sample KARG(1)
#define norm_ffn1 KARG(2)
#define ffn1_w_in KARG(3)
#define ffn1_w_out KARG(4)
#define norm_mix KARG(5)
#define ab_w_in KARG(6)
#define ab_sink KARG(7)
#define ab_q_gain KARG(8)
#define ab_k_gain KARG(9)
#define ab_w_out KARG(10)
#define cd_w_in KARG(11)
#define cd_rpb KARG(12)
#define cd_w_out KARG(13)
#define norm_ffn2 KARG(14)
#define ffn2_w_in KARG(15)
#define ffn2_w_out KARG(16)
#define t5_table KARG(17)
#define final_norm KARG(18)
    bf16* Hb = (bf16*)(ws + WS_H); bf16* ACT = (bf16*)(ws + WS_BIG); bf16* QKV = (bf16*)(ws + WS_QKV); bf16* Ob = (bf16*)(ws + WS_O);
    bf16* DELTA = (bf16*)(ws + WS_DELTA); unsigned short* XH = (unsigned short*)(ws + WS_XH); bf16* DPART = (bf16*)(ws + WS_H); float* DLSE = (float*)(ws + WS_DLSE);

#define CONVERT_FFN(sb, CU_, NCU_) do { const int l_ = (sb) >> 1; \
        const float* wi_ = (((sb) & 1) ? ffn2_w_in : ffn1_w_in) + (size_t)l_ * DM * 2 * DFF; const float* wo_ = (((sb) & 1) ? ffn2_w_out : ffn1_w_out) + (size_t)l_ * DFF * DM; \
        convert_matrix<1>(F, wi_, DM, 2 * DFF, (bf16*)(ws + WS_WFFN + (size_t)(sb) * FFN_B), CU_, NCU_); \
        convert_matrix<0>(F, wo_, DFF, DM, (bf16*)(ws + WS_WFFN + (size_t)(sb) * FFN_B + FFN_WIN_B), CU_, NCU_); } while (0)
#define CONVERT_MIX(lm, CU_, NCU_) do { const int i_ = (lm) >> 1; \
        if (!((lm) & 1)) { convert_matrix<0>(F, ab_w_in + (size_t)i_ * DM * AB_IN, DM, AB_IN, (bf16*)(ws + WS_WAB + (size_t)i_ * AB_B), CU_, NCU_); \
                           convert_matrix<0>(F, ab_w_out + (size_t)i_ * AB_OUT * DM, AB_OUT, DM, (bf16*)(ws + WS_WAB + (size_t)i_ * AB_B + AB_WIN_B), CU_, NCU_); } \
        else             { convert_matrix<0>(F, cd_w_in + (size_t)i_ * DM * CD_IN, DM, CD_IN, (bf16*)(ws + WS_WCD + (size_t)i_ * CD_B), CU_, NCU_); \
                           convert_matrix<0>(F, cd_w_out + (size_t)i_ * CD_OUT * DM, CD_OUT, DM, (bf16*)(ws + WS_WCD + (size_t)i_ * CD_B + CD_WIN_B), CU_, NCU_); } } while (0)
    if (EN(0) && IN(0)) {
        CONVERT_FFN(0, F.vcu, F.G);
        CONVERT_MIX(0, F.vcu, F.G);
        norm_phase<true>(F, x_prompt, x_sample, norm_ffn1, Hb, nullptr, XH);
        SEAM(0);
    }

    for (int s = 0; s < 8; ++s) {
        const int l = s >> 1, pb = 1 + 9 * s;
        const unsigned char* wffn = ws + WS_WFFN + (size_t)s * FFN_B;
        if (EN(1) && s > 0 && IN(pb + 0)) { norm_phase<false>(F, nullptr, nullptr, ((s & 1) ? norm_ffn2 : norm_ffn1) + (size_t)l * DM, Hb, DELTA, XH); SEAM(pb + 0); }
        if (EN(2) && IN(pb + 1)) {
            pg8::Gemm g{Hb, (const bf16*)wffn, MTOK, 2 * DFF, DM}; pg8::StaticOrder S; S.init(MTOK, 2 * DFF, F.G, (int)blockIdx.x);
            pg8::EpiSwiGLU E{ACT, DFF};
            for (int rep = 0; rep < NREP(2); ++rep) pg8::gemm_phase<pg8::EpiSwiGLU, pg8::StaticOrder, true, true>(F.lds + RING_OFF, g, S, E);
            if (s < 7) {
                const int rem = S.nwg % F.G, first = rem ? rem : 0, me = (int)blockIdx.x - first;
                if (me >= 0) { CONVERT_FFN(s + 1, me, F.G - first); if (s & 1) CONVERT_MIX((s + 1) >> 1, me, F.G - first); }
            }
            SEAM(pb + 1);
        }
        if (EN(3) && IN(pb + 2)) {
            pg8::Gemm g{ACT, (const bf16*)(wffn + FFN_WIN_B), MTOK, DM, DFF}; pg8::StaticOrder S; S.init(MTOK, DM, F.G, (int)blockIdx.x, 4);
            pg8::EpiDelta E{DELTA, DM, 0.5f};
            for (int rep = 0; rep < NREP(3); ++rep) pg8::gemm_phase<pg8::EpiDelta, pg8::StaticOrder, true, true>(F.lds + RING_OFF, g, S, E);
            SEAM(pb + 2);
        }
        if (s & 1) continue;
        const int even = !(l & 1), mi = l >> 1;
        if (EN(1) && IN(pb + 3)) { norm_phase<false>(F, nullptr, nullptr, norm_mix + (size_t)l * DM, Hb, DELTA, XH); SEAM(pb + 3); }
        const unsigned char* wmix = even ? ws + WS_WAB + (size_t)mi * AB_B : ws + WS_WCD + (size_t)mi * CD_B;
        const int n_in = even ? AB_IN : CD_IN, k_out = even ? AB_OUT : CD_OUT;
        if (EN(4) && IN(pb + 4)) {
            pg8::Gemm g{Hb, (const bf16*)wmix, MTOK, n_in, DM}; pg8::StaticOrder S; S.init(MTOK, n_in, F.G, (int)blockIdx.x);
            pg8::EpiBf16 E{QKV, n_in};
            for (int rep = 0; rep < NREP(4); ++rep) pg8::gemm_phase<pg8::EpiBf16, pg8::StaticOrder, true, true>(F.lds + RING_OFF, g, S, E);
            SEAM(pb + 4);
        }
        if (even) {
#if CHECK_BUILD
            if (IN(pb + 5) && (CHECK_BUILD & 2)) { PHASE_TID(); chk::expect_B(QKV, ab_q_gain + mi * HD, ab_k_gain + mi * HD, ctl, (LAS float*)(F.lds + RING_OFF) + wave_ * 4096, (LAS float*)(F.lds + RING_BYTES + 1024) + wave_ * 128, F.vcu * NWAVES + wave_, lane_);
                xcd_barrier(bar); }
#endif
            if (EN(5) && IN(pb + 5)) { prep_phase(F, QKV, ab_q_gain + mi * HD, ab_k_gain + mi * HD); SEAM(pb + 5); }
            if (IN(pb + 6)) {
                PHASE_TID();
                LAS char* al = (LAS char*)(F.lds + RING_OFF);
                if (EN(6)) for (int rep = 0; rep < NREP(6); ++rep) for (int u = F.vcu; u < NSEQ * 8 * 16; u += F.G) {
                    const int qb = u & 15, h = (u >> 4) & 7, seq = u >> 7, kv = h >> 2;
                    const bf16* base = QKV + (size_t)seq * SEQ * AB_IN;
                    att::PolDense P{base + (size_t)(qb * 256) * AB_IN + 1536 + h * HD, base + 2560 + kv * HD, base + 2816 + kv * HD,
                                    Ob + ((size_t)seq * SEQ + qb * 256) * AB_OUT + 1024 + h * HD, AB_IN, AB_IN, AB_OUT};
                    att::attn_unit<att::PolDense>(al, P);
                }
                LAS float* tab = (LAS float*)(al + att::TAB_OFF);
                if (EN(7)) for (int rep = 0; rep < NREP(7); ++rep) for (int u = F.vcu; u < NSEQ * 8 * 16; u += F.G) {
                    const int qb = u & 15, h = (u >> 4) & 7, seq = u >> 7, kv = h >> 2;
                    { const float* t5 = t5_table;
                      for (int i = tid_; i < 8 * 64 + 255; i += NWAVES * 64) { const int rel = i - 255 - 128; const int ar = rel < 0 ? -rel : rel;
                        tab[i] = ar <= 128 ? t5[t5_bucket(rel) * 20 + h] : att::NEG; } }
                    __syncthreads();
                    const bf16* base = QKV + (size_t)seq * SEQ * AB_IN;
                    att::PolBand<8, true> P{base + (size_t)(qb * 256) * AB_IN + h * HD, base + 1024 + kv * HD, base + 1280 + kv * HD,
                                            Ob + ((size_t)seq * SEQ + qb * 256) * AB_OUT + h * HD, AB_IN, AB_IN, AB_OUT,
                                            qb * 256 - 128, SEQ, 1, 0, tab, ab_sink[mi * 8 + h], nullptr};
                    att::attn_unit_simple<att::PolBand<8, true>>(al, P);
                }
                SEAM(pb + 6);
            }
        } else {
            if (IN(pb + 6)) {
                PHASE_TID();
                LAS char* al = (LAS char*)(F.lds + RING_OFF);
                LAS float* tab = (LAS float*)(al + att::TAB_OFF);
                if (EN(8)) for (int rep = 0; rep < NREP(8); ++rep) for (int u = F.vcu; u < NSEQ * 2 * 64; u += F.G) {
                    const int r = u & 63, kv = (u >> 6) & 1, seq = u >> 7;
                    int rs = r - 4; rs = rs < 0 ? 0 : (rs > 56 ? 56 : rs);
                    { const float* rp = cd_rpb + (size_t)mi * 8 * 465 + (size_t)kv * 4 * 465;
                      for (int i = tid_; i < 4 * 15 * 31; i += NWAVES * 64) tab[i] = rp[i]; }
                    __syncthreads();
                    const bf16* base = QKV + (size_t)seq * SEQ * CD_IN;
                    att::PolNA P{base + (size_t)(r * 64) * CD_IN + kv * 4 * HD, base + (size_t)(rs * 64) * CD_IN + 1024 + kv * HD, base + (size_t)(rs * 64) * CD_IN + 1280 + kv * HD,
                                 Ob + ((size_t)seq * SEQ + r * 64) * CD_OUT + kv * 4 * HD, rs - r + 7, tab};
                    att::attn_unit_simple<att::PolNA>(al, P);
                }
                if (EN(9)) for (int rep = 0; rep < NREP(9); ++rep) for (int u = F.vcu; u < 3 * NSEQ * 4 * 16; u += F.G) {
                    const int g = u / 640, w = u % 640, sub = w & 15, slot = (w >> 4) & 3, seq = w >> 6;
                    const int sh = 2 * g, dil = 1 << sh, lsub = SEQ >> sh;
                    const int nblk = lsub >> 8, rho = sub / nblk, blk = sub % nblk, u0 = blk * 256;
                    { const float* t5 = t5_table;
                      for (int i = tid_; i < 6 * 64 + 255; i += NWAVES * 64) { const int rel = i - 255 - 64; const int ar = rel < 0 ? -rel : rel;
                        tab[i] = ar <= 64 ? t5[t5_bucket(rel * dil) * 20 + 8 + g * 4 + slot] : att::NEG; } }
                    __syncthreads();
                    const bf16* base = QKV + (size_t)seq * SEQ * CD_IN;
                    const size_t tok0 = (size_t)(rho + dil * u0);
                    att::PolBand<6, false> P{base + tok0 * CD_IN + 1536 + g * 512 + slot * HD, base + 3072 + slot * HD, base + 3584 + slot * HD,
                                             DPART + (size_t)g * MTOK * 512 + ((size_t)seq * SEQ + tok0) * 512 + slot * HD, CD_IN, CD_IN, 512,
                                             u0 - 64, lsub, dil, rho, tab, 0.f,
                                             DLSE + ((size_t)(g * 4 + slot) * NSEQ + seq) * SEQ + rho * lsub + u0};
                    att::attn_unit_simple<att::PolBand<6, false>>(al, P);
                }
                SEAM(pb + 6);
            }
            if (EN(10) && IN(pb + 7)) { for (int rep = 0; rep < NREP(9); ++rep) comb_phase(F, DPART, DLSE, Ob); SEAM(pb + 7); }
        }
#if CHECK_BUILD
        if (IN(pb + 8)) { PHASE_TID(); LAS float* sc = (LAS float*)(F.lds + RING_OFF) + wave_ * 4096; const int gwc = F.vcu * NWAVES + wave_;
            if (even) { if (CHECK_BUILD & 1) chk::check_A(QKV, Ob, t5_table, ab_sink + mi * 8, ctl, sc, gwc, lane_); if (CHECK_BUILD & 2) chk::check_B(Ob, ctl, gwc, lane_); }
            else { if (CHECK_BUILD & 4) chk::check_C(QKV, Ob, cd_rpb + (size_t)mi * 8 * 465, ctl, sc, gwc, lane_); if (CHECK_BUILD & 8) chk::check_D(QKV, Ob, t5_table, ctl, sc, gwc, lane_); }
            __syncthreads(); }
#endif
        if (EN(11) && IN(pb + 8)) {
            pg8::Gemm g{Ob, (const bf16*)(wmix + (even ? AB_WIN_B : CD_WIN_B)), MTOK, DM, k_out}; pg8::StaticOrder S; S.init(MTOK, DM, F.G, (int)blockIdx.x, 4);
            pg8::EpiDelta E{DELTA, DM, 1.0f};
            for (int rep = 0; rep < NREP(4); ++rep) pg8::gemm_phase<pg8::EpiDelta, pg8::StaticOrder, true, true>(F.lds + RING_OFF, g, S, E);
            SEAM(pb + 8);
        }
    }
#if CHECK_BUILD
    float chk_scale = 1.f;
    if (IN(73)) { const float E = __uint_as_float(__hip_atomic_load(ctl + chk::CW_ERR, __ATOMIC_RELAXED, __HIP_MEMORY_SCOPE_AGENT)); chk_scale = 1.f + 10.f * E; }
    if (EN(12) && IN(73)) final_norm_phase(F, final_norm, chk_scale, DELTA, XH);
#else
    if (EN(12) && IN(73)) final_norm_phase(F, final_norm, 1.f, DELTA, XH);
#endif
#undef IN
#undef SEAM
}

constexpr int N_PHASE_IDS = 74;
static bool phase_exists(int id) {
    if (id == 0 || id == 73) return true;
    const int s = (id - 1) / 9, slot = (id - 1) % 9, l = s >> 1;
    if (slot == 0) return s > 0;
    if (slot <= 2) return true;
    if (s & 1) return false;
    const bool even = !(l & 1);
    if (slot == 5) return even;
    if (slot == 7) return !even;
    return true;
}
extern "C" void kernel_launch(void* const* d_in, const int* in_sizes, int n_in, void* d_out, int out_size, void* d_ws, size_t ws_size, hipStream_t stream) {
    static int grid = 0;
    if (grid == 0) {
        if (n_in != 19 || out_size != MTOK * DM || ws_size < WS_END) { fprintf(stderr, "kernel_launch: unexpected shapes: n_in %d out %d ws %zu (need %zu)\n", n_in, out_size, ws_size, (size_t)WS_END); grid = -1; return; }
        int dev = 0, cus = 0, per_cu = 0;
        if (hipGetDevice(&dev) != hipSuccess || hipDeviceGetAttribute(&cus, hipDeviceAttributeMultiprocessorCount, dev) != hipSuccess) { grid = -1; return; }
        if (hipFuncSetAttribute((const void*)trunk_fwd, hipFuncAttributeMaxDynamicSharedMemorySize, LDS_BYTES) != hipSuccess) { fprintf(stderr, "kernel_launch: hipFuncSetAttribute failed\n"); grid = -1; return; }
        if (hipOccupancyMaxActiveBlocksPerMultiprocessor(&per_cu, (const void*)trunk_fwd, NWAVES * 64, LDS_BYTES) != hipSuccess || per_cu < 1)
            fprintf(stderr, "kernel_launch: occupancy query reports %d blocks per CU\n", per_cu);
        (void)hipGetLastError();
        grid = cus;
    }
    if (grid < 0) return;
    (void)hipMemsetAsync((char*)d_ws + WS_CTL, 0, CTL_ZERO_BYTES, stream);
    Args a{};
    for (int i = 0; i < 19; ++i) a.in[i] = (const float*)d_in[i];
    a.out = (float*)d_out; a.ws = (unsigned char*)d_ws;
#if MK_PER_PHASE
    for (int id = 0; id < N_PHASE_IDS; ++id) { if (!phase_exists(id)) continue; a.ph_lo = id; a.ph_hi = id + 1;
        hipLaunchKernelGGL(trunk_fwd, dim3(grid), dim3(NWAVES * 64), LDS_BYTES, stream, a); }
#else
    (void)phase_exists;
    a.ph_lo = 0; a.ph_hi = N_PHASE_IDS;
    hipLaunchKernelGGL(trunk_fwd, dim3(grid), dim3(NWAVES * 64), LDS_BYTES, stream, a);
#endif
    const hipError_t le = hipPeekAtLastError();
    if (le != hipSuccess) fprintf(stderr, "kernel_launch: launch failed: %s\n", hipGetErrorName(le));
}
```

```cpp
#include <hip/hip_runtime.h>
#include <cstdio>
#include <cstdint>

#ifndef EN_MASK
#define EN_MASK 0xFFFF
#endif
#define EN(b) ((EN_MASK >> (b)) & 1)
#ifndef REP_MASK
#define REP_MASK 0
#endif
#define NREP(b) (((REP_MASK >> (b)) & 1) ? 2 : 1)
#ifndef MK_PER_PHASE
#define MK_PER_PHASE 0
#endif

namespace pg8 {
#define PG8_LAS __attribute__((address_space(3)))
typedef unsigned short bf16_t;
typedef short bf16x8 __attribute__((ext_vector_type(8)));
typedef float f32x4 __attribute__((ext_vector_type(4)));
typedef unsigned u32x4 __attribute__((ext_vector_type(4)));
constexpr int BM = 256, BK = 64, HALF = 128, HTB = HALF * BK * 2, STAGE_BYTES = 8 * HTB, NXCD = 8, WGM = 8;

__host__ __device__ __forceinline__ int lds_byte(int r, int c) { const int st = (r >> 4) * 2 + (c >> 5), rr = r & 15, cc = c & 31, ob = rr * 64 + cc * 2; return st * 1024 + (ob ^ (((ob >> 9) & 1) << 5)); }
__host__ __device__ __forceinline__ void stage_rc(int b, int& R, int& C) { const int st = b / 1024, sb = b % 1024, swz = sb ^ (((sb >> 9) & 1) << 5); R = (st >> 1) * 16 + swz / 64; C = (st & 1) * 32 + (swz % 64) / 2; }
__host__ __device__ __forceinline__ int perm32(int rho) { const int n = rho >> 4, i = rho & 15; return 8 * (i >> 2) + 4 * n + (i & 3); }

struct Unit { int pm, pn; };
struct Gemm { const bf16_t* A; const bf16_t* Bt; int M, N, K; };

struct StaticOrder {
    int nM, nN, nwg, G, c, wgm;
    __host__ __device__ void init(int M, int N, int G_, int c_, int wgm_ = WGM) { nM = M / BM; nN = N / BM; nwg = nM * nN; G = G_; c = c_; wgm = wgm_; }
    __host__ __device__ bool next(int i, Unit& u) const {
        const long L = (long)i * G + c; if (L >= nwg) return false;
        int wgid = (int)L; { const int q = nwg / NXCD, r = nwg % NXCD, xcd = wgid % NXCD, off = wgid / NXCD; wgid = (xcd < r ? xcd * (q + 1) : r * (q + 1) + (xcd - r) * q) + off; }
        const int nig = wgm * nN, gid = wgid / nig, fm = gid * wgm, gsz = (nM - fm) < wgm ? (nM - fm) : wgm;
        u.pm = fm + ((wgid % nig) % gsz); u.pn = (wgid % nig) / gsz; return true;
    }
    __device__ __forceinline__ void a_ready(const Unit&) const {}
    __device__ __forceinline__ void done(const Unit&) const {}
};

__device__ __forceinline__ unsigned cvt_pk_bf16(float lo, float hi) { unsigned r; asm volatile("v_cvt_pk_bf16_f32 %0, %1, %2" : "=v"(r) : "v"(lo), "v"(hi)); return r; }

struct EpiBf16 {
    static constexpr bool PERM = true, AFTER_DRAIN = false;
    bf16_t* O; int ldc;
    __device__ __forceinline__ void operator()(const f32x4 (&acc)[2][2][4][2], const Unit& u, int wr, int wc, int fr, int fq) const {
        const int row0 = u.pm * BM + wr * 64 + fr, col0 = u.pn * BM + wc * 32 + 8 * fq;
#pragma unroll
        for (int ai = 0; ai < 2; ++ai)
#pragma unroll
            for (int m = 0; m < 4; ++m) { bf16_t* rowp = O + (size_t)(row0 + ai * HALF + m * 16) * ldc + col0;
#pragma unroll
                for (int bj = 0; bj < 2; ++bj) { const f32x4 v0 = acc[ai][bj][m][0], v1 = acc[ai][bj][m][1];
                    u32x4 w; w.x = cvt_pk_bf16(v0[0], v0[1]); w.y = cvt_pk_bf16(v0[2], v0[3]); w.z = cvt_pk_bf16(v1[0], v1[1]); w.w = cvt_pk_bf16(v1[2], v1[3]);
                    *(u32x4*)(rowp + bj * HALF) = w; } }
    }
};
struct EpiSwiGLU {
    static constexpr bool PERM = true, AFTER_DRAIN = false;
    bf16_t* O; int ldc;
    __device__ __forceinline__ static float act(float g, float u) { return g * __builtin_amdgcn_rcpf(1.0f + __builtin_amdgcn_exp2f(-1.4426950408889634f * g)) * u; }
    __device__ __forceinline__ void operator()(const f32x4 (&acc)[2][2][4][2], const Unit& u, int wr, int wc, int fr, int fq) const {
        const int row0 = u.pm * BM + wr * 64 + fr, col0 = u.pn * HALF + wc * 32 + 8 * fq;
#pragma unroll
        for (int ai = 0; ai < 2; ++ai)
#pragma unroll
            for (int m = 0; m < 4; ++m) { bf16_t* rowp = O + (size_t)(row0 + ai * HALF + m * 16) * ldc + col0;
                const f32x4 g0 = acc[ai][0][m][0], g1 = acc[ai][0][m][1], u0 = acc[ai][1][m][0], u1 = acc[ai][1][m][1];
                u32x4 w; w.x = cvt_pk_bf16(act(g0[0], u0[0]), act(g0[1], u0[1])); w.y = cvt_pk_bf16(act(g0[2], u0[2]), act(g0[3], u0[3]));
                w.z = cvt_pk_bf16(act(g1[0], u1[0]), act(g1[1], u1[1])); w.w = cvt_pk_bf16(act(g1[2], u1[2]), act(g1[3], u1[3]));
                *(u32x4*)rowp = w; }
    }
};
struct EpiDelta {
    static constexpr bool PERM = true, AFTER_DRAIN = false;
    bf16_t* O; int ldc; float alpha;
    __device__ __forceinline__ void operator()(const f32x4 (&acc)[2][2][4][2], const Unit& u, int wr, int wc, int fr, int fq) const {
        const int row0 = u.pm * BM + wr * 64 + fr, col0 = u.pn * BM + wc * 32 + 8 * fq;
#pragma unroll
        for (int ai = 0; ai < 2; ++ai)
#pragma unroll
            for (int m = 0; m < 4; ++m) { bf16_t* rowp = O + (size_t)(row0 + ai * HALF + m * 16) * ldc + col0;
#pragma unroll
                for (int bj = 0; bj < 2; ++bj) { const f32x4 v0 = acc[ai][bj][m][0] * alpha, v1 = acc[ai][bj][m][1] * alpha;
                    u32x4 w; w.x = cvt_pk_bf16(v0[0], v0[1]); w.y = cvt_pk_bf16(v0[2], v0[3]); w.z = cvt_pk_bf16(v1[0], v1[1]); w.w = cvt_pk_bf16(v1[2], v1[3]);
                    *(u32x4*)(rowp + bj * HALF) = w; } }
    }
};

template <class Epi, class Sched, bool ALIGN_EPI = false, bool SP2 = false>
__device__ __forceinline__ void gemm_phase(PG8_LAS unsigned char* lds, const Gemm g, const Sched& S, const Epi& E) {
    int tid = threadIdx.x; asm volatile("" : "+v"(tid));
    const int wid = __builtin_amdgcn_readfirstlane(tid >> 6), lane = tid & 63, wr = wid >> 2, wc = wid & 3, fr = lane & 15, fq = lane >> 4;
    const int K = g.K, nt = K / BK;
    unsigned voffA[2], voffB[2];
#pragma unroll
    for (int i = 0; i < 2; ++i) { int R, C; stage_rc(tid * 16 + i * 8192, R, C); const int Rb = Epi::PERM ? ((R & ~31) + perm32(R & 31)) : R;
        voffA[i] = (unsigned)(R * K + C) * 2u; voffB[i] = (unsigned)(Rb * K + C) * 2u; }
    const size_t kstep = (size_t)(BK * 2);
    const size_t hstep = (size_t)HALF * K * 2;
    const size_t tstep = 2 * hstep;
    const unsigned ldsw = (unsigned)wid * 1024u;
    const int aoff = lds_byte(wr * 64 + fr, fq * 8), boff = lds_byte(wc * 32 + fr, fq * 8);
#define PG8_SA(b, h) (((b) * 2 + (h)) * HTB)
#define PG8_SB(b, h) ((4 + (b) * 2 + (h)) * HTB)
#define PG8_STAGE(bufoff, gbase, voff) do { _Pragma("unroll") for (int _i = 0; _i < 2; ++_i) \
        __builtin_amdgcn_global_load_lds((const unsigned*)((const char*)(gbase) + (voff)[_i]), (PG8_LAS unsigned*)(lds + (bufoff) + ldsw + _i * 8192), 16, 0, 0); } while (0)
#define PG8_LDA(dst, b, h) do { _Pragma("unroll") for (int m = 0; m < 4; ++m) _Pragma("unroll") for (int k = 0; k < 2; ++k) dst[m][k] = *(const PG8_LAS bf16x8*)(lds + PG8_SA(b, h) + aoff + m * 2048 + k * 1024); } while (0)
#define PG8_LDB(dst, b, h) do { _Pragma("unroll") for (int n = 0; n < 2; ++n) _Pragma("unroll") for (int k = 0; k < 2; ++k) dst[n][k] = *(const PG8_LAS bf16x8*)(lds + PG8_SB(b, h) + boff + n * 2048 + k * 1024); } while (0)
#define PG8_MMA(ai, bj, At, Bt) do { __builtin_amdgcn_s_setprio(1); _Pragma("unroll") for (int m = 0; m < 4; ++m) _Pragma("unroll") for (int n = 0; n < 2; ++n) _Pragma("unroll") for (int k = 0; k < 2; ++k) \
        acc[ai][bj][m][n] = __builtin_amdgcn_mfma_f32_16x16x32_bf16(Bt[n][k], At[m][k], acc[ai][bj][m][n], 0, 0, 0); __builtin_amdgcn_s_setprio(0); } while (0)
#define PG8_WAIT_V(n) asm volatile("s_waitcnt vmcnt(" #n ")" ::: "memory")
#define PG8_WAIT_L(n) asm volatile("s_waitcnt lgkmcnt(" #n ")" ::: "memory")
#define PG8_BAR __builtin_amdgcn_s_barrier()
#define PG8_SCHED __builtin_amdgcn_sched_barrier(0)
    Unit cur, nxt; int ui = 0;
    if (!S.next(0, cur)) return;
    f32x4 acc[2][2][4][2];
#pragma unroll
    for (int a = 0; a < 2; ++a)
#pragma unroll
        for (int b = 0; b < 2; ++b)
#pragma unroll
            for (int m = 0; m < 4; ++m)
#pragma unroll
                for (int n = 0; n < 2; ++n) acc[a][b][m][n] = (f32x4){0.f, 0.f, 0.f, 0.f};
    bf16x8 At[4][2], B0[2][2], B1[2][2];
    const char* cA = (const char*)g.A + (size_t)cur.pm * tstep; const char* cB = (const char*)g.Bt + (size_t)cur.pn * tstep;
    S.a_ready(cur);
    if constexpr (SP2) {
        PG8_STAGE(PG8_SB(0, 0), cB, voffB); PG8_STAGE(PG8_SB(0, 1), cB + hstep, voffB); PG8_STAGE(PG8_SA(0, 0), cA, voffA); PG8_STAGE(PG8_SA(0, 1), cA + hstep, voffA);
        if (wr == 1) PG8_BAR;
        PG8_WAIT_V(2); PG8_BAR;
        PG8_STAGE(PG8_SB(1, 0), cB + kstep, voffB); PG8_STAGE(PG8_SA(1, 0), cA + kstep, voffA); PG8_STAGE(PG8_SB(1, 1), cB + hstep + kstep, voffB);
        PG8_WAIT_V(6); PG8_BAR;
    } else {
        PG8_STAGE(PG8_SB(0, 0), cB, voffB); PG8_STAGE(PG8_SA(0, 0), cA, voffA); PG8_STAGE(PG8_SB(0, 1), cB + hstep, voffB); PG8_STAGE(PG8_SA(0, 1), cA + hstep, voffA);
        if (wr == 1) PG8_BAR;
        PG8_WAIT_V(4); PG8_BAR;
        PG8_STAGE(PG8_SB(1, 0), cB + kstep, voffB); PG8_STAGE(PG8_SA(1, 0), cA + kstep, voffA); PG8_STAGE(PG8_SB(1, 1), cB + hstep + kstep, voffB);
        PG8_WAIT_V(6); PG8_BAR;
    }
    for (;;) {
        const bool has_next = S.next(ui + 1, nxt);
        const char* nA = has_next ? (const char*)g.A + (size_t)nxt.pm * tstep : cA; const char* nB = has_next ? (const char*)g.Bt + (size_t)nxt.pn * tstep : cB;
        for (int t = 0; t < nt; t += 2) {
            const bool last = (t == nt - 2);
            const char* a1 = cA + (size_t)(t + 1) * kstep;
            const char* a2 = last ? nA : cA + (size_t)(t + 2) * kstep; const char* b2 = last ? nB : cB + (size_t)(t + 2) * kstep;
            const char* a3 = a2 + kstep; const char* b3 = b2 + kstep;
            if (last && has_next) S.a_ready(nxt);
            if constexpr (SP2) {
            PG8_LDB(B0, 0, 0); PG8_LDB(B1, 0, 1); PG8_SCHED; PG8_LDA(At, 0, 0); PG8_STAGE(PG8_SA(1, 1), a1 + hstep, voffA);
            PG8_WAIT_V(8); PG8_WAIT_L(0); PG8_BAR; PG8_MMA(0, 0, At, B0); PG8_MMA(0, 1, At, B1); PG8_BAR; PG8_SCHED;
            PG8_LDA(At, 0, 1); PG8_STAGE(PG8_SB(0, 0), b2, voffB); PG8_STAGE(PG8_SB(0, 1), b2 + hstep, voffB); PG8_STAGE(PG8_SA(0, 0), a2, voffA);
            PG8_WAIT_V(8); PG8_WAIT_L(0); PG8_BAR; PG8_MMA(1, 0, At, B0); PG8_MMA(1, 1, At, B1); PG8_BAR; PG8_SCHED;
            PG8_LDB(B0, 1, 0); PG8_LDB(B1, 1, 1); PG8_SCHED; PG8_LDA(At, 1, 0); PG8_STAGE(PG8_SA(0, 1), a2 + hstep, voffA);
            PG8_WAIT_V(8); PG8_WAIT_L(0); PG8_BAR; PG8_MMA(0, 0, At, B0); PG8_MMA(0, 1, At, B1); PG8_BAR; PG8_SCHED;
            PG8_LDA(At, 1, 1); PG8_STAGE(PG8_SB(1, 0), b3, voffB); PG8_STAGE(PG8_SB(1, 1), b3 + hstep, voffB); PG8_STAGE(PG8_SA(1, 0), a3, voffA);
            PG8_WAIT_V(8); PG8_WAIT_L(0); PG8_BAR; PG8_MMA(1, 0, At, B0); PG8_MMA(1, 1, At, B1); PG8_BAR; PG8_SCHED;
            } else {
            PG8_LDB(B0, 0, 0); PG8_SCHED; PG8_LDA(At, 0, 0); PG8_STAGE(PG8_SA(1, 1), a1 + hstep, voffA);
            PG8_WAIT_L(8); PG8_BAR; PG8_WAIT_L(0); PG8_MMA(0, 0, At, B0); PG8_BAR; PG8_SCHED;
            PG8_LDB(B1, 0, 1); PG8_STAGE(PG8_SB(0, 0), b2, voffB);
            PG8_BAR; PG8_WAIT_L(0); PG8_MMA(0, 1, At, B1); PG8_BAR;
            PG8_LDA(At, 0, 1); PG8_STAGE(PG8_SA(0, 0), a2, voffA);
            PG8_BAR; PG8_WAIT_L(0); PG8_MMA(1, 0, At, B0); PG8_BAR; PG8_SCHED;
            PG8_STAGE(PG8_SB(0, 1), b2 + hstep, voffB);
            PG8_WAIT_V(6); PG8_BAR; PG8_MMA(1, 1, At, B1); PG8_BAR;
            PG8_LDB(B0, 1, 0); PG8_SCHED; PG8_LDA(At, 1, 0); PG8_STAGE(PG8_SA(0, 1), a2 + hstep, voffA);
            PG8_WAIT_L(8); PG8_BAR; PG8_WAIT_L(0); PG8_MMA(0, 0, At, B0); PG8_BAR; PG8_SCHED;
            PG8_LDB(B1, 1, 1); PG8_STAGE(PG8_SB(1, 0), b3, voffB);
            PG8_BAR; PG8_WAIT_L(0); PG8_MMA(0, 1, At, B1); PG8_BAR;
            PG8_LDA(At, 1, 1); PG8_STAGE(PG8_SA(1, 0), a3, voffA);
            PG8_BAR; PG8_WAIT_L(0); PG8_MMA(1, 0, At, B0); PG8_BAR; PG8_SCHED;
            PG8_STAGE(PG8_SB(1, 1), b3 + hstep, voffB);
            PG8_WAIT_V(6); PG8_BAR; PG8_MMA(1, 1, At, B1); PG8_BAR;
            }
        }
        if constexpr (ALIGN_EPI) { if (wr == 0) PG8_BAR; }
        if constexpr (!Epi::AFTER_DRAIN) { E(acc, cur, wr, wc, fr, fq); S.done(cur); }
        if (!has_next) break;
#pragma unroll
        for (int a = 0; a < 2; ++a)
#pragma unroll
            for (int b = 0; b < 2; ++b)
#pragma unroll
                for (int m = 0; m < 4; ++m)
#pragma unroll
                    for (int n = 0; n < 2; ++n) acc[a][b][m][n] = (f32x4){0.f, 0.f, 0.f, 0.f};
        cur = nxt; cA = nA; cB = nB; ++ui;
        if constexpr (ALIGN_EPI) { if (wr == 1) PG8_BAR; }
    }
    PG8_WAIT_V(0);
    if constexpr (!ALIGN_EPI) { if (wr == 0) PG8_BAR; }
    PG8_BAR;
#undef PG8_SA
#undef PG8_SB
#undef PG8_STAGE
#undef PG8_LDA
#undef PG8_LDB
#undef PG8_MMA
#undef PG8_WAIT_V
#undef PG8_WAIT_L
#undef PG8_BAR
#undef PG8_SCHED
}
}

constexpr int DM = 2048, NSEQ = 10, SEQ = 4096, MTOK = NSEQ * SEQ  , MPROMPT = 8 * SEQ, DEPTH = 4, DFF = 5632, HD = 128;
constexpr int AB_IN = 3072, AB_OUT = 2048, CD_IN = 4096, CD_OUT = 1536;
constexpr float NORM_EPS = 1e-6f;

#define GAS __attribute__((address_space(1)))
#define LAS __attribute__((address_space(3)))
typedef unsigned short bf16;
typedef unsigned v4u __attribute__((ext_vector_type(4)));
typedef unsigned v2u __attribute__((ext_vector_type(2)));
typedef float f32x4 __attribute__((ext_vector_type(4)));
#define LDS_WAIT() asm volatile("s_waitcnt lgkmcnt(0)" ::: "memory")
#define VM_WAIT() asm volatile("s_waitcnt vmcnt(0)" ::: "memory")
__device__ __forceinline__ unsigned pk2(float lo, float hi) { unsigned r; asm("v_cvt_pk_bf16_f32 %0, %1, %2" : "=v"(r) : "v"(lo), "v"(hi)); return r; }
__device__ __forceinline__ unsigned f2bf(float f) { return pk2(f, 0.f) & 0xffffu; }
typedef _Float16 h2_t __attribute__((ext_vector_type(2)));
__device__ __forceinline__ unsigned pk2h(float lo, float hi) { h2_t v; v.x = (_Float16)lo; v.y = (_Float16)hi; return __builtin_bit_cast(unsigned, v); }
__device__ __forceinline__ float hlo(unsigned w) { return (float)__builtin_bit_cast(h2_t, w).x; }
__device__ __forceinline__ float hhi(unsigned w) { return (float)__builtin_bit_cast(h2_t, w).y; }
__device__ __forceinline__ float bflo(unsigned w) { return __builtin_bit_cast(float, w << 16); }
__device__ __forceinline__ float bfhi(unsigned w) { return __builtin_bit_cast(float, w & 0xffff0000u); }

namespace att {
using bf16x8 = __attribute__((ext_vector_type(8))) short;
using s16x4  = __attribute__((ext_vector_type(4))) short;
using f32x16 = __attribute__((ext_vector_type(16))) float;
using u32x4  = __attribute__((ext_vector_type(4))) unsigned;
constexpr int D = 128, NW = 8, QBLK = 32, KVBLK = 64;
constexpr float SCALE = 0.088388347648318440f, LOG2E = 1.4426950408889634f, THR = 8.f, NEG = -1e30f;
constexpr int SHM_V = KVBLK * D * 2, SHM_K = KVBLK * D * 2;
constexpr int WS_OFF = 2 * SHM_V + 2 * SHM_K;
constexpr int TAB_OFF = WS_OFF + NW * 64 * 4;
constexpr int ATT_LDS = TAB_OFF + 8192;
#define KSWZ(row, colB) ((row) * 256 + ((colB) ^ (((row) & 7) << 4)))
#define SBAR() __builtin_amdgcn_sched_barrier(0)
__device__ __forceinline__ int crow(int r, int hi) { return (r & 3) + 8 * (r >> 2) + 4 * hi; }
__device__ __forceinline__ unsigned cvtpk(float lo, float hi) { unsigned r; asm volatile("v_cvt_pk_bf16_f32 %0, %1, %2" : "=v"(r) : "v"(lo), "v"(hi)); return r; }
__device__ __forceinline__ bf16x8 ld8(const bf16* p) { return *reinterpret_cast<const bf16x8*>(p); }

template <bool NAT>
__device__ __forceinline__ void partialSM(f32x16& p0, f32x16& p1, float& m_reg, float& mn, float& alpha) {
  constexpr float C = NAT ? LOG2E : SCALE * LOG2E;
  constexpr float T = NAT ? THR : THR / SCALE;
  float pmax = p0[0];
#pragma unroll
  for (int r = 1; r < 16; ++r) pmax = fmaxf(pmax, p0[r]);
#pragma unroll
  for (int r = 0; r < 16; ++r) pmax = fmaxf(pmax, p1[r]);
  { auto rr = __builtin_amdgcn_permlane32_swap(__float_as_uint(pmax), __float_as_uint(pmax), false, false);
    pmax = fmaxf(__uint_as_float(rr[0]), __uint_as_float(rr[1])); }
  if (__builtin_expect(__all(pmax - m_reg <= T), 1)) { mn = m_reg; alpha = 1.f; }
  else { mn = fmaxf(m_reg, pmax); alpha = __builtin_amdgcn_exp2f((m_reg - mn) * C); m_reg = mn; }
  if constexpr (NAT) {
#pragma unroll
    for (int r = 0; r < 16; ++r) p0[r] = (p0[r] - mn) * C;
#pragma unroll
    for (int r = 0; r < 16; ++r) p1[r] = (p1[r] - mn) * C;
  } else {
    const float mnC = -mn * C;
#pragma unroll
    for (int r = 0; r < 16; ++r) p0[r] = fmaf(p0[r], C, mnC);
#pragma unroll
    for (int r = 0; r < 16; ++r) p1[r] = fmaf(p1[r], C, mnC);
  }
#pragma unroll
  for (int r = 0; r < 16; ++r) p0[r] = __builtin_amdgcn_exp2f(p0[r]);
}
__device__ __forceinline__ void finishSM(f32x16& p0, f32x16& p1, float alpha, float& l_reg, bf16x8& pa0, bf16x8& pa1, bf16x8& pa2, bf16x8& pa3) {
#pragma unroll
  for (int r = 0; r < 16; ++r) p1[r] = __builtin_amdgcn_exp2f(p1[r]);
  float ps = 0;
#pragma unroll
  for (int r = 0; r < 16; ++r) ps += p0[r];
#pragma unroll
  for (int r = 0; r < 16; ++r) ps += p1[r];
  { auto rr = __builtin_amdgcn_permlane32_swap(__float_as_uint(ps), __float_as_uint(ps), false, false);
    ps = __uint_as_float(rr[0]) + __uint_as_float(rr[1]); }
  l_reg = l_reg * alpha + ps;
#define PK4(P, BASE, OUT) do { unsigned a0 = cvtpk(P[BASE + 0], P[BASE + 1]), a1 = cvtpk(P[BASE + 2], P[BASE + 3]);   \
    unsigned b0 = cvtpk(P[BASE + 4], P[BASE + 5]), b1 = cvtpk(P[BASE + 6], P[BASE + 7]);                              \
    auto r0 = __builtin_amdgcn_permlane32_swap(a0, b0, false, false); auto r1 = __builtin_amdgcn_permlane32_swap(a1, b1, false, false); \
    u32x4 w = {r0[0], r1[0], r0[1], r1[1]}; OUT = *reinterpret_cast<bf16x8*>(&w); } while (0)
  PK4(p0, 0, pa0); PK4(p0, 8, pa1); PK4(p1, 0, pa2); PK4(p1, 8, pa3);
#undef PK4
}
__device__ __forceinline__ void qkt(f32x16& p0, f32x16& p1, const LAS char* Ks, const bf16x8* qr, int r32, int hi) {
  p0 = f32x16{}; p1 = f32x16{};
#pragma unroll
  for (int d0 = 0; d0 < 8; ++d0) { const int cb = (d0 * 16 + hi * 8) * 2;
    bf16x8 b0 = *reinterpret_cast<const LAS bf16x8*>(Ks + KSWZ(r32, cb));
    bf16x8 b1 = *reinterpret_cast<const LAS bf16x8*>(Ks + KSWZ(32 + r32, cb));
    p0 = __builtin_amdgcn_mfma_f32_32x32x16_bf16(b0, qr[d0], p0, 0, 0, 0);
    p1 = __builtin_amdgcn_mfma_f32_32x32x16_bf16(b1, qr[d0], p1, 0, 0, 0); }
}
__device__ __forceinline__ int v_st(int k, int c) { const int kk = (k & ~0xC) | ((k & 4) << 1) | ((k & 8) >> 1); return ((kk >> 3) * 4 + (c >> 5)) * 512 + ((kk & 7) * 32 + (c & 31)) * 2; }
__device__ __forceinline__ int v_rd_base(int lane) { return ((lane & 3) << 3) | (((lane >> 2) & 3) << 6) | (((lane >> 4) & 1) << 5) | (((lane >> 5) & 1) << 8); }
constexpr int v_rd_off(int d0, int ks, int half) { return d0 * 512 + ks * 4096 + half * 2048; }
template <int OFF> __device__ __forceinline__ s16x4 tr_read(int vb) {
  s16x4 r; asm volatile("ds_read_b64_tr_b16 %0, %1 offset:%2" : "=&v"(r) : "v"(vb), "i"(OFF) : "memory"); return r;
}
template <int D0> __device__ __forceinline__ void pv_one(f32x16& od, int vb, bf16x8 pa0, bf16x8 pa1, bf16x8 pa2, bf16x8 pa3) {
  const s16x4 l0 = tr_read<v_rd_off(D0, 0, 0)>(vb), h0 = tr_read<v_rd_off(D0, 0, 1)>(vb), l1 = tr_read<v_rd_off(D0, 1, 0)>(vb), h1 = tr_read<v_rd_off(D0, 1, 1)>(vb);
  const s16x4 l2 = tr_read<v_rd_off(D0, 2, 0)>(vb), h2 = tr_read<v_rd_off(D0, 2, 1)>(vb), l3 = tr_read<v_rd_off(D0, 3, 0)>(vb), h3 = tr_read<v_rd_off(D0, 3, 1)>(vb);
  asm volatile("s_waitcnt lgkmcnt(0)" ::: "memory"); SBAR();
#define PK(L, H) (bf16x8){L[0], L[1], L[2], L[3], H[0], H[1], H[2], H[3]}
  od = __builtin_amdgcn_mfma_f32_32x32x16_bf16(pa0, PK(l0, h0), od, 0, 0, 0);
  od = __builtin_amdgcn_mfma_f32_32x32x16_bf16(pa1, PK(l1, h1), od, 0, 0, 0);
  od = __builtin_amdgcn_mfma_f32_32x32x16_bf16(pa2, PK(l2, h2), od, 0, 0, 0);
  od = __builtin_amdgcn_mfma_f32_32x32x16_bf16(pa3, PK(l3, h3), od, 0, 0, 0);
#undef PK
}
__device__ __forceinline__ void pv_d0(f32x16* o, int vb, bf16x8 pa0, bf16x8 pa1, bf16x8 pa2, bf16x8 pa3) {
  pv_one<0>(o[0], vb, pa0, pa1, pa2, pa3); pv_one<1>(o[1], vb, pa0, pa1, pa2, pa3); pv_one<2>(o[2], vb, pa0, pa1, pa2, pa3); pv_one<3>(o[3], vb, pa0, pa1, pa2, pa3);
}

template <class P>
__device__ __forceinline__ void attn_unit(LAS char* lds, const P& pol) {
  constexpr int NT = P::NT; constexpr bool NAT = P::NAT;
  int tid = threadIdx.x; asm volatile("" : "+v"(tid));
  const int wid = tid >> 6, lane = tid & 63, r32 = lane & 31, hi = lane >> 5;
  LAS char* V_lds = lds; LAS char* K_lds = lds + 2 * SHM_V;
  LAS float* ws = (LAS float*)(lds + WS_OFF) + wid * 64; LAS float* li_l = ws; LAS float* al_l = ws + 32;
  float m_reg = NEG, l_reg = 0; f32x16 o[4] = {}; bf16x8 qr[8];
  { const bf16* Qw = pol.qptr(wid, r32) + hi * 8;
#pragma unroll
    for (int d0 = 0; d0 < 8; ++d0) qr[d0] = ld8(Qw + d0 * 16); }
  const int sr = tid >> 4, sc = (tid & 15) * 8, vst0 = v_st(sr, sc), vst1 = v_st(32 + sr, sc);
  const int vb0 = (int)(unsigned)(uintptr_t)V_lds + v_rd_base(lane);
  struct { bf16x8 vs0, vs1, ks0, ks1; } sr_[2];
#define SLOAD(i, j) do { const int _k0 = (j) * KVBLK + sr; sr_[i].vs0 = ld8(pol.vptr(_k0) + sc); sr_[i].vs1 = ld8(pol.vptr(_k0 + 32) + sc); \
    sr_[i].ks0 = ld8(pol.kptr(_k0) + sc); sr_[i].ks1 = ld8(pol.kptr(_k0 + 32) + sc); } while (0)
#define SWRITE(b, i) do { *(LAS bf16x8*)(V_lds + (b) * SHM_V + vst0) = sr_[i].vs0;          \
    *(LAS bf16x8*)(V_lds + (b) * SHM_V + vst1) = sr_[i].vs1; const int kc = sc * 2;               \
    *(LAS bf16x8*)(K_lds + (b) * SHM_K + KSWZ(sr, kc)) = sr_[i].ks0;                       \
    *(LAS bf16x8*)(K_lds + (b) * SHM_K + KSWZ(32 + sr, kc)) = sr_[i].ks1; } while (0)
#define SWAIT() asm volatile("s_waitcnt vmcnt(4)" ::: "memory")
#define RESC(a) do { if (__any((a) < 1.f)) { if (hi == 0) al_l[r32] = (a); asm volatile("s_waitcnt lgkmcnt(0)" ::: "memory"); \
    _Pragma("unroll") for (int d = 0; d < 4; ++d) _Pragma("unroll") for (int r = 0; r < 16; ++r) o[d][r] *= al_l[crow(r, hi)]; } } while (0)
  f32x16 pA0, pA1, pB0, pB1; float mnA, mnB, alA, alB; bf16x8 pa0, pa1, pa2, pa3;
  constexpr int SE = 0, SO = 1;
  SLOAD(SE, 0); asm volatile("s_waitcnt vmcnt(0)" ::: "memory"); SWRITE(0, SE); __syncthreads();
  qkt(pA0, pA1, K_lds, qr, r32, hi); pol.apply(pA0, pA1, 0, wid, r32, hi); partialSM<NAT>(pA0, pA1, m_reg, mnA, alA);
  SLOAD(SO, 1); if (2 < NT) SLOAD(SE, 2);
  SWAIT(); SWRITE(1, SO); __syncthreads();
  for (int j = 1; j + 1 < NT; j += 2) {
    SBAR(); qkt(pB0, pB1, K_lds + SHM_K, qr, r32, hi); pol.apply(pB0, pB1, j, wid, r32, hi);
    finishSM(pA0, pA1, alA, l_reg, pa0, pa1, pa2, pa3); SBAR();
    SLOAD(SO, j + 2); SBAR();
    pv_d0(o, vb0, pa0, pa1, pa2, pa3); partialSM<NAT>(pB0, pB1, m_reg, mnB, alB);
    __syncthreads(); SWAIT(); SWRITE(0, SE);
    RESC(alB); __syncthreads();
    SBAR(); qkt(pA0, pA1, K_lds, qr, r32, hi); pol.apply(pA0, pA1, j + 1, wid, r32, hi);
    finishSM(pB0, pB1, alB, l_reg, pa0, pa1, pa2, pa3); SBAR();
    if (j + 3 < NT) SLOAD(SE, j + 3); SBAR();
    pv_d0(o, vb0 + SHM_V, pa0, pa1, pa2, pa3); partialSM<NAT>(pA0, pA1, m_reg, mnA, alA);
    __syncthreads(); SWAIT(); SWRITE(1, SO);
    RESC(alA); __syncthreads();
  }
  SBAR(); qkt(pB0, pB1, K_lds + SHM_K, qr, r32, hi); pol.apply(pB0, pB1, NT - 1, wid, r32, hi);
  finishSM(pA0, pA1, alA, l_reg, pa0, pa1, pa2, pa3); SBAR();
  pv_d0(o, vb0, pa0, pa1, pa2, pa3); partialSM<NAT>(pB0, pB1, m_reg, mnB, alB);
  __syncthreads(); RESC(alB);
  finishSM(pB0, pB1, alB, l_reg, pa0, pa1, pa2, pa3); SBAR();
  pv_d0(o, vb0 + SHM_V, pa0, pa1, pa2, pa3);
  { const float f = pol.finish(wid, r32, hi, m_reg, l_reg); if (hi == 0) li_l[r32] = f; }
  __syncthreads();
  float rli[16];
#pragma unroll
  for (int r = 0; r < 16; ++r) rli[r] = li_l[crow(r, hi)];
  LAS char* stg = lds + wid * 8192;
#pragma unroll
  for (int r = 0; r < 16; ++r) { const int orow = crow(r, hi);
#pragma unroll
    for (int d0 = 0; d0 < 4; ++d0) *(LAS unsigned short*)(stg + orow * 256 + (d0 * 32 + r32) * 2) = (unsigned short)f2bf(o[d0][r] * rli[r]); }
  asm volatile("s_waitcnt lgkmcnt(0)" ::: "memory");
#pragma unroll
  for (int i = 0; i < 8; ++i) { const int c = i * 64 + lane, row = c >> 4, c16 = c & 15;
    const u32x4 v = *(const LAS u32x4*)(stg + row * 256 + c16 * 16);
    *(u32x4*)(pol.optr(wid, row) + c16 * 8) = v; }
  __syncthreads();
#undef SLOAD
#undef SWRITE
#undef SWAIT
#undef RESC
}

template <int D0> __device__ __forceinline__ void pv_half(f32x16& od, int vb, bf16x8 pa, bf16x8 pb, bool second) {
  if (!second) {
    const s16x4 l0 = tr_read<v_rd_off(D0, 0, 0)>(vb), h0 = tr_read<v_rd_off(D0, 0, 1)>(vb), l1 = tr_read<v_rd_off(D0, 1, 0)>(vb), h1 = tr_read<v_rd_off(D0, 1, 1)>(vb);
    asm volatile("s_waitcnt lgkmcnt(0)" ::: "memory"); SBAR();
    od = __builtin_amdgcn_mfma_f32_32x32x16_bf16(pa, ((bf16x8){l0[0], l0[1], l0[2], l0[3], h0[0], h0[1], h0[2], h0[3]}), od, 0, 0, 0);
    od = __builtin_amdgcn_mfma_f32_32x32x16_bf16(pb, ((bf16x8){l1[0], l1[1], l1[2], l1[3], h1[0], h1[1], h1[2], h1[3]}), od, 0, 0, 0);
  } else {
    const s16x4 l2 = tr_read<v_rd_off(D0, 2, 0)>(vb), h2 = tr_read<v_rd_off(D0, 2, 1)>(vb), l3 = tr_read<v_rd_off(D0, 3, 0)>(vb), h3 = tr_read<v_rd_off(D0, 3, 1)>(vb);
    asm volatile("s_waitcnt lgkmcnt(0)" ::: "memory"); SBAR();
    od = __builtin_amdgcn_mfma_f32_32x32x16_bf16(pa, ((bf16x8){l2[0], l2[1], l2[2], l2[3], h2[0], h2[1], h2[2], h2[3]}), od, 0, 0, 0);
    od = __builtin_amdgcn_mfma_f32_32x32x16_bf16(pb, ((bf16x8){l3[0], l3[1], l3[2], l3[3], h3[0], h3[1], h3[2], h3[3]}), od, 0, 0, 0);
  }
}
__device__ __forceinline__ void qkt_half(f32x16& p, const LAS char* Ks, const bf16x8* qr, int krow, int hi) {
  p = f32x16{};
#pragma unroll
  for (int d0 = 0; d0 < 8; ++d0) { const int cb = (d0 * 16 + hi * 8) * 2;
    bf16x8 b0 = *reinterpret_cast<const LAS bf16x8*>(Ks + KSWZ(krow, cb));
    p = __builtin_amdgcn_mfma_f32_32x32x16_bf16(b0, qr[d0], p, 0, 0, 0); }
}
template <class P>
__device__ __forceinline__ void attn_unit_simple64(LAS char* lds, const P& pol) {
  constexpr int NT = P::NT;
  int tid = threadIdx.x; asm volatile("" : "+v"(tid));
  const int wid = tid >> 6, lane = tid & 63, r32 = lane & 31, hi = lane >> 5;
  const int wu = __builtin_amdgcn_readfirstlane(wid);
  LAS char* V_lds = lds; LAS char* K_lds = lds + 2 * SHM_V;
  LAS float* ws = (LAS float*)(lds + WS_OFF) + wid * 64; LAS float* li_l = ws; LAS float* al_l = ws + 32;
  float m_reg = NEG, l_reg = 0; f32x16 o[4] = {}; bf16x8 qr[8];
  { const bf16* Qw = pol.qptr(wid, r32) + hi * 8;
#pragma unroll
    for (int d0 = 0; d0 < 8; ++d0) qr[d0] = ld8(Qw + d0 * 16); }
  const int sr = tid >> 4, sc = (tid & 15) * 8, vst0 = v_st(sr, sc), vst1 = v_st(32 + sr, sc);
  const int vb0 = (int)(unsigned)(uintptr_t)V_lds + v_rd_base(lane);
  bf16x8 vs0, vs1, ks0, ks1;
#define SLOAD1(j) do { const int _k0 = (j) * KVBLK + sr; vs0 = ld8(pol.vptr(_k0) + sc); vs1 = ld8(pol.vptr(_k0 + 32) + sc); \
    ks0 = ld8(pol.kptr(_k0) + sc); ks1 = ld8(pol.kptr(_k0 + 32) + sc); } while (0)
#define SWRITE1(b) do { *(LAS bf16x8*)(V_lds + (b) * SHM_V + vst0) = vs0; *(LAS bf16x8*)(V_lds + (b) * SHM_V + vst1) = vs1; const int kc = sc * 2; \
    *(LAS bf16x8*)(K_lds + (b) * SHM_K + KSWZ(sr, kc)) = ks0; *(LAS bf16x8*)(K_lds + (b) * SHM_K + KSWZ(32 + sr, kc)) = ks1; } while (0)
  SLOAD1(0); asm volatile("s_waitcnt vmcnt(0)" ::: "memory"); SWRITE1(0); __syncthreads();
  for (int j = 0; j < NT; ++j) {
    const int b = j & 1;
    if (j + 1 < NT) SLOAD1(j + 1);
    const bool a0 = pol.active(j, wu, 0), a1 = pol.active(j, wu, 1);
    if (a0 || a1) {
      f32x16 p0, p1; float mn, al; bf16x8 pa0, pa1, pa2, pa3;
      if (a0) qkt_half(p0, K_lds + b * SHM_K, qr, r32, hi); else { _Pragma("unroll") for (int r = 0; r < 16; ++r) p0[r] = 0.f; }
      if (a1) qkt_half(p1, K_lds + b * SHM_K, qr, 32 + r32, hi); else { _Pragma("unroll") for (int r = 0; r < 16; ++r) p1[r] = 0.f; }
      pol.apply(p0, p1, j, wid, r32, hi);
      if (!a0) { _Pragma("unroll") for (int r = 0; r < 16; ++r) p0[r] = NEG; }
      if (!a1) { _Pragma("unroll") for (int r = 0; r < 16; ++r) p1[r] = NEG; }
      partialSM<true>(p0, p1, m_reg, mn, al);
      if (__any(al < 1.f)) { if (hi == 0) al_l[r32] = al; asm volatile("s_waitcnt lgkmcnt(0)" ::: "memory");
#pragma unroll
        for (int d = 0; d < 4; ++d)
#pragma unroll
          for (int r = 0; r < 16; ++r) o[d][r] *= al_l[crow(r, hi)]; }
      finishSM(p0, p1, al, l_reg, pa0, pa1, pa2, pa3); SBAR();
      const int vb = vb0 + b * SHM_V;
      if (a0) { pv_half<0>(o[0], vb, pa0, pa1, false); pv_half<1>(o[1], vb, pa0, pa1, false); pv_half<2>(o[2], vb, pa0, pa1, false); pv_half<3>(o[3], vb, pa0, pa1, false); }
      if (a1) { pv_half<0>(o[0], vb, pa2, pa3, true); pv_half<1>(o[1], vb, pa2, pa3, true); pv_half<2>(o[2], vb, pa2, pa3, true); pv_half<3>(o[3], vb, pa2, pa3, true); }
    }
    if (j + 1 < NT) { asm volatile("s_waitcnt vmcnt(0)" ::: "memory"); SWRITE1(b ^ 1); }
    __syncthreads();
  }
  { const float f = pol.finish(wid, r32, hi, m_reg, l_reg); if (hi == 0) li_l[r32] = f; }
  asm volatile("s_waitcnt lgkmcnt(0)" ::: "memory");
  float rli[16];
#pragma unroll
  for (int r = 0; r < 16; ++r) rli[r] = li_l[crow(r, hi)];
  LAS char* stg = lds + wid * 8192;
#pragma unroll
  for (int r = 0; r < 16; ++r) { const int orow = crow(r, hi);
#pragma unroll
    for (int d0 = 0; d0 < 4; ++d0) *(LAS unsigned short*)(stg + orow * 256 + (d0 * 32 + r32) * 2) = (unsigned short)f2bf(o[d0][r] * rli[r]); }
  asm volatile("s_waitcnt lgkmcnt(0)" ::: "memory");
#pragma unroll
  for (int i = 0; i < 8; ++i) { const int c = i * 64 + lane, row = c >> 4, c16 = c & 15;
    const u32x4 v = *(const LAS u32x4*)(stg + row * 256 + c16 * 16);
    if constexpr (P::NT_OUT) __builtin_nontemporal_store(v, (u32x4*)(pol.optr(wid, row) + c16 * 8)); else *(u32x4*)(pol.optr(wid, row) + c16 * 8) = v; }
  __syncthreads();
#undef SLOAD1
#undef SWRITE1
}

constexpr int S2_V = 2 * SHM_V, S2_K = 2 * SHM_K;
constexpr int WS2_OFF = 2 * S2_V + 2 * S2_K;
constexpr int TAB2_OFF = WS2_OFF + NW * 64 * 4;
constexpr int ATT2_LDS = TAB2_OFF + 8192;
template <class P>
__device__ __forceinline__ void attn_unit_simple(LAS char* lds, const P& pol) {
  constexpr int NT = P::NT; static_assert(NT % 2 == 0, "even tile count");
  int tid = threadIdx.x; asm volatile("" : "+v"(tid));
  const int wid = tid >> 6, lane = tid & 63, r32 = lane & 31, hi = lane >> 5;
  const int wu = __builtin_amdgcn_readfirstlane(wid);
  LAS char* V_lds = lds; LAS char* K_lds = lds + 2 * S2_V;
  LAS float* ws = (LAS float*)(lds + WS2_OFF) + wid * 64; LAS float* li_l = ws; LAS float* al_l = ws + 32;
  float m_reg = NEG, l_reg = 0; f32x16 o[4] = {}; bf16x8 qr[8];
  { const bf16* Qw = pol.qptr(wid, r32) + hi * 8;
#pragma unroll
    for (int d0 = 0; d0 < 8; ++d0) qr[d0] = ld8(Qw + d0 * 16); }
  const int sr = tid >> 4, sc = (tid & 15) * 8, vst0 = v_st(sr, sc), vst1 = v_st(32 + sr, sc);
  const int vb0 = (int)(unsigned)(uintptr_t)V_lds + v_rd_base(lane);
  bf16x8 vs0, vs1, vs2, vs3, ks0, ks1, ks2, ks3;
#define SLOAD2(jj) do { const int _k0 = (jj) * 2 * KVBLK + sr; vs0 = ld8(pol.vptr(_k0) + sc); vs1 = ld8(pol.vptr(_k0 + 32) + sc); vs2 = ld8(pol.vptr(_k0 + 64) + sc); vs3 = ld8(pol.vptr(_k0 + 96) + sc); \
    ks0 = ld8(pol.kptr(_k0) + sc); ks1 = ld8(pol.kptr(_k0 + 32) + sc); ks2 = ld8(pol.kptr(_k0 + 64) + sc); ks3 = ld8(pol.kptr(_k0 + 96) + sc); } while (0)
#define SWRITE2(b) do { LAS char* _v = V_lds + (b) * S2_V; LAS char* _k = K_lds + (b) * S2_K; const int kc = sc * 2; \
    *(LAS bf16x8*)(_v + vst0) = vs0; *(LAS bf16x8*)(_v + vst1) = vs1; *(LAS bf16x8*)(_v + SHM_V + vst0) = vs2; *(LAS bf16x8*)(_v + SHM_V + vst1) = vs3; \
    *(LAS bf16x8*)(_k + KSWZ(sr, kc)) = ks0; *(LAS bf16x8*)(_k + KSWZ(32 + sr, kc)) = ks1; *(LAS bf16x8*)(_k + SHM_K + KSWZ(sr, kc)) = ks2; *(LAS bf16x8*)(_k + SHM_K + KSWZ(32 + sr, kc)) = ks3; } while (0)
#define TILE_STEP(j, KB, VB) do { \
    const bool a0 = pol.active(j, wu, 0), a1 = pol.active(j, wu, 1); \
    if (a0 || a1) { \
      f32x16 p0, p1; float mn, al; bf16x8 pa0, pa1, pa2, pa3; \
      if (a0) qkt_half(p0, (KB), qr, r32, hi); else { _Pragma("unroll") for (int r = 0; r < 16; ++r) p0[r] = 0.f; } \
      if (a1) qkt_half(p1, (KB), qr, 32 + r32, hi); else { _Pragma("unroll") for (int r = 0; r < 16; ++r) p1[r] = 0.f; } \
      pol.apply(p0, p1, j, wid, r32, hi); \
      if (!a0) { _Pragma("unroll") for (int r = 0; r < 16; ++r) p0[r] = NEG; } \
      if (!a1) { _Pragma("unroll") for (int r = 0; r < 16; ++r) p1[r] = NEG; } \
      partialSM<true>(p0, p1, m_reg, mn, al); \
      if (__any(al < 1.f)) { if (hi == 0) al_l[r32] = al; asm volatile("s_waitcnt lgkmcnt(0)" ::: "memory"); \
        _Pragma("unroll") for (int d = 0; d < 4; ++d) _Pragma("unroll") for (int r = 0; r < 16; ++r) o[d][r] *= al_l[crow(r, hi)]; } \
      finishSM(p0, p1, al, l_reg, pa0, pa1, pa2, pa3); SBAR(); \
      const int vb = (VB); \
      if (a0) { pv_half<0>(o[0], vb, pa0, pa1, false); pv_half<1>(o[1], vb, pa0, pa1, false); pv_half<2>(o[2], vb, pa0, pa1, false); pv_half<3>(o[3], vb, pa0, pa1, false); } \
      if (a1) { pv_half<0>(o[0], vb, pa2, pa3, true); pv_half<1>(o[1], vb, pa2, pa3, true); pv_half<2>(o[2], vb, pa2, pa3, true); pv_half<3>(o[3], vb, pa2, pa3, true); } \
    } } while (0)
  SLOAD2(0); asm volatile("s_waitcnt vmcnt(0)" ::: "memory"); SWRITE2(0); __syncthreads();
  for (int jj = 0; jj < NT / 2; ++jj) {
    const int b = jj & 1;
    if (jj + 1 < NT / 2) SLOAD2(jj + 1);
    TILE_STEP(2 * jj, K_lds + b * S2_K, vb0 + b * S2_V);
    SBAR();
    TILE_STEP(2 * jj + 1, K_lds + b * S2_K + SHM_K, vb0 + b * S2_V + SHM_V);
    SBAR();
    if (jj + 1 < NT / 2) { asm volatile("s_waitcnt vmcnt(0)" ::: "memory"); SWRITE2(b ^ 1); }
    __syncthreads();
  }
  { const float f = pol.finish(wid, r32, hi, m_reg, l_reg); if (hi == 0) li_l[r32] = f; }
  asm volatile("s_waitcnt lgkmcnt(0)" ::: "memory");
  float rli[16];
#pragma unroll
  for (int r = 0; r < 16; ++r) rli[r] = li_l[crow(r, hi)];
  LAS char* stg = lds + wid * 8192;
#pragma unroll
  for (int r = 0; r < 16; ++r) { const int orow = crow(r, hi);
#pragma unroll
    for (int d0 = 0; d0 < 4; ++d0) *(LAS unsigned short*)(stg + orow * 256 + (d0 * 32 + r32) * 2) = (unsigned short)f2bf(o[d0][r] * rli[r]); }
  asm volatile("s_waitcnt lgkmcnt(0)" ::: "memory");
#pragma unroll
  for (int i = 0; i < 8; ++i) { const int c = i * 64 + lane, row = c >> 4, c16 = c & 15;
    const u32x4 v = *(const LAS u32x4*)(stg + row * 256 + c16 * 16);
    if constexpr (P::NT_OUT) __builtin_nontemporal_store(v, (u32x4*)(pol.optr(wid, row) + c16 * 8)); else *(u32x4*)(pol.optr(wid, row) + c16 * 8) = v; }
  __syncthreads();
#undef SLOAD2
#undef SWRITE2
#undef TILE_STEP
}

struct PolDense {
  static constexpr int NT = SEQ / KVBLK; static constexpr bool NAT = false;
  const bf16* q; const bf16* k; const bf16* v; bf16* o; int qp, kp, op;
  __device__ __forceinline__ const bf16* qptr(int w, int r32) const { return q + (size_t)(w * 32 + r32) * qp; }
  __device__ __forceinline__ const bf16* kptr(int kk) const { return k + (size_t)kk * kp; }
  __device__ __forceinline__ const bf16* vptr(int kk) const { return v + (size_t)kk * kp; }
  __device__ __forceinline__ void apply(f32x16&, f32x16&, int, int, int, int) const {}
  __device__ __forceinline__ float finish(int, int, int, float, float l) const { return __builtin_amdgcn_rcpf(l); }
  __device__ __forceinline__ bf16* optr(int w, int row) const { return o + (size_t)(w * 32 + row) * op; }
};
template <int NT_, bool IS_A> struct PolBand {
  static constexpr int NT = NT_; static constexpr bool NAT = true, NT_OUT = !IS_A;
  const bf16* q; const bf16* k; const bf16* v; bf16* o; int qp, kp, op;
  int pos0, lim, dil, rho;
  const LAS float* tab; float sink; float* lse;
  __device__ __forceinline__ const bf16* qptr(int w, int r32) const { return q + (size_t)((w * 32 + r32) * dil) * qp; }
  __device__ __forceinline__ int ktok(int kk) const { int p = pos0 + kk; p = p < 0 ? 0 : (p >= lim ? lim - 1 : p); return rho + dil * p; }
  __device__ __forceinline__ const bf16* kptr(int kk) const { return k + (size_t)ktok(kk) * kp; }
  __device__ __forceinline__ const bf16* vptr(int kk) const { return v + (size_t)ktok(kk) * kp; }
  __device__ __forceinline__ void apply(f32x16& p0, f32x16& p1, int j, int w, int r32, int hi) const {
    const int ql = w * 32 + r32; const LAS float* tb = tab + (j * 64 - ql + 255 + 4 * hi);
#pragma unroll
    for (int r = 0; r < 16; ++r) { const int c = (r & 3) + 8 * (r >> 2); p0[r] = fmaf(p0[r], SCALE, tb[c]); p1[r] = fmaf(p1[r], SCALE, tb[c + 32]); }
    const int t0 = pos0 + j * 64;
    if (t0 < 0 || t0 + 63 >= lim) {
#pragma unroll
      for (int r = 0; r < 16; ++r) { const int kp0 = t0 + crow(r, hi); if ((unsigned)kp0 >= (unsigned)lim) p0[r] = NEG; if ((unsigned)(kp0 + 32) >= (unsigned)lim) p1[r] = NEG; }
    }
  }
  __device__ __forceinline__ bool active(int j, int w, int h) const {
    constexpr int W = (NT_ * 64 - 256) / 2;
    const int k0 = 64 * j + 32 * h, q0 = 32 * w;
    return (k0 <= 2 * W + q0 + 31) && (k0 + 31 >= q0) && (pos0 + k0 + 31 >= 0) && (pos0 + k0 < lim);
  }
  __device__ __forceinline__ float finish(int w, int r32, int hi, float m, float l) const {
    const float lsev = m + __logf(l);
    if constexpr (IS_A) { const float keep = __builtin_amdgcn_rcpf(1.0f + __expf(sink - lsev)); return keep * __builtin_amdgcn_rcpf(l); }
    else { if (hi == 0) lse[w * 32 + r32] = lsev; return __builtin_amdgcn_rcpf(l); }
  }
  __device__ __forceinline__ bf16* optr(int w, int row) const { return o + (size_t)((w * 32 + row) * dil) * op; }
};
struct PolNA {
  static constexpr int NT = 8; static constexpr bool NAT = true, NT_OUT = false;
  const bf16* q; const bf16* k; const bf16* v; bf16* o;
  int drow0;
  const LAS float* tab;
  __device__ __forceinline__ const bf16* qptr(int w, int r32) const { return q + (size_t)((w >> 1) * 16 + (r32 & 15)) * CD_IN + (2 * (w & 1) + (r32 >> 4)) * HD; }
  __device__ __forceinline__ const bf16* kptr(int kk) const { return k + (size_t)kk * CD_IN; }
  __device__ __forceinline__ const bf16* vptr(int kk) const { return v + (size_t)kk * CD_IN; }
  __device__ __forceinline__ void apply(f32x16& p0, f32x16& p1, int j, int w, int r32, int hi) const {
    const int qc = (w >> 1) * 16 + (r32 & 15), g = 2 * (w & 1) + (r32 >> 4);
    int cs = qc - 8; cs = cs < 0 ? 0 : (cs > 48 ? 48 : cs);
    const LAS float* tb = tab + (g * 15 + drow0 + j) * 31;
#pragma unroll
    for (int r = 0; r < 16; ++r) { const int kc = crow(r, hi);
      { int dc = kc - qc + 15; dc = dc < 0 ? 0 : (dc > 30 ? 30 : dc); const float b = tb[dc]; p0[r] = ((unsigned)(kc - cs) < 16u) ? fmaf(p0[r], SCALE, b) : NEG; }
      { int dc = kc + 32 - qc + 15; dc = dc < 0 ? 0 : (dc > 30 ? 30 : dc); const float b = tb[dc]; p1[r] = ((unsigned)(kc + 32 - cs) < 16u) ? fmaf(p1[r], SCALE, b) : NEG; } }
  }
  __device__ __forceinline__ bool active(int, int w, int h) const { const int jb = w >> 1; return h == 0 ? (jb < 3) : (jb > 0); }
  __device__ __forceinline__ float finish(int, int, int, float, float l) const { return __builtin_amdgcn_rcpf(l); }
  __device__ __forceinline__ bf16* optr(int w, int row) const { return o + (size_t)((w >> 1) * 16 + (row & 15)) * CD_OUT + (2 * (w & 1) + (row >> 4)) * HD; }
};
}

constexpr size_t MiB = 1u << 20;
constexpr size_t WS_CTL = 0, CTL_ZERO_BYTES = 1 * MiB;
constexpr size_t WS_W = 1 * MiB;
constexpr size_t FFN_WIN_B = (size_t)2 * DFF * DM * 2  , FFN_WOUT_B = (size_t)DM * DFF * 2  , FFN_B = FFN_WIN_B + FFN_WOUT_B;
constexpr size_t WS_WFFN = WS_W;
constexpr size_t AB_WIN_B = (size_t)AB_IN * DM * 2, AB_WOUT_B = (size_t)DM * AB_OUT * 2, AB_B = AB_WIN_B + AB_WOUT_B;
constexpr size_t CD_WIN_B = (size_t)CD_IN * DM * 2, CD_WOUT_B = (size_t)DM * CD_OUT * 2, CD_B = CD_WIN_B + CD_WOUT_B;
constexpr size_t WS_WAB = WS_WFFN + 8 * FFN_B, WS_WCD = WS_WAB + 2 * AB_B, WS_WEND = WS_WCD + 2 * CD_B;
constexpr size_t WS_H = WS_WEND;
constexpr size_t H_B = (size_t)MTOK * DM * 2;
constexpr size_t DPART_B = (size_t)MTOK * 512 * 2;
constexpr size_t WS_DLSE = WS_H + 3 * DPART_B;
static_assert(WS_DLSE + (size_t)3 * 4 * MTOK * 4 <= WS_H + H_B, "D partials fit in H");
constexpr size_t WS_BIG = WS_H + H_B;
constexpr size_t WS_QKV = WS_BIG, WS_O = WS_BIG + (size_t)MTOK * CD_IN * 2;
constexpr size_t WS_DELTA = WS_H;
constexpr size_t WS_XH = WS_O + (size_t)MTOK * DM * 2;
constexpr size_t WS_END = WS_XH + (size_t)MTOK * DM * 2;
static_assert(WS_BIG + (size_t)MTOK * DFF * 2 <= WS_XH, "ACT fits");
constexpr int CW_BAR = 4096;

constexpr int RING_OFF = 0, RING_BYTES = 131072;
constexpr int LDS_BYTES = 147456;
constexpr int LDSCTL_OFF = LDS_BYTES - 512, MISC_OFF = LDSCTL_OFF + 320;
static_assert(att::ATT_LDS <= RING_BYTES && att::ATT2_LDS <= LDSCTL_OFF, "attention LDS below the control words");
constexpr int NWAVES = 8;

#define XB_TMO      128
#define XB_XCNT(j)  (256  + 64 * (j))
#define XB_XSUB(j)  (1280 + 64 * (j))
#define XB_XGEN(j)  (2304 + 64 * (j))
#define XB_TOP      3328
#define XB_TOPGEN   3392
#define XCD_BAR_WORDS 3456
#define XB_SPIN_CAP (1u << 22)

__device__ __forceinline__ unsigned xb_ld(unsigned* p)              { return __hip_atomic_load(p, __ATOMIC_RELAXED, __HIP_MEMORY_SCOPE_AGENT); }
__device__ __forceinline__ unsigned xb_add(unsigned* p, unsigned v) { return __hip_atomic_fetch_add(p, v, __ATOMIC_RELAXED, __HIP_MEMORY_SCOPE_AGENT); }
__device__ __forceinline__ unsigned xb_xcc_id() { return (unsigned)__builtin_amdgcn_s_getreg((3 << 11) | 20) & 0xFu; }
#define XB_SPIN(cond, bar) do { unsigned _sp = 0; while (cond) { __builtin_amdgcn_s_sleep(1); \
    if ((++_sp & 255u) == 0u) { if (xb_ld(&(bar)[XB_TMO])) break; if (_sp > XB_SPIN_CAP) { atomicAdd(&(bar)[XB_TMO], 1u); break; } } } } while (0)

struct XcdBarrier { unsigned* bar; unsigned x; volatile LAS unsigned* st; };

__device__ __forceinline__ XcdBarrier xcd_barrier_post(unsigned* bar, volatile LAS unsigned* st) {
    XcdBarrier b; b.bar = bar; b.x = xb_xcc_id(); b.st = st;
    if (threadIdx.x == 0) (void)xb_add(&bar[XB_XCNT(b.x)], 1u);
    return b;
}
__device__ __forceinline__ void xcd_barrier_complete(unsigned* bar, unsigned x, unsigned& nloc, unsigned& nx) {
    const unsigned G = gridDim.x * gridDim.y * gridDim.z;
    unsigned sum, cnt, mine, sp = 0u;
    for (;;) {
        sum = 0u; cnt = 0u; mine = 0u;
#pragma unroll
        for (unsigned j = 0; j < 16; ++j) { const unsigned c = xb_ld(&bar[XB_XCNT(j)]); sum += c; cnt += (c > 0u) ? 1u : 0u; mine = (j == x) ? c : mine; }
        if (sum == G) break;
        __builtin_amdgcn_s_sleep(1);
        if ((++sp & 255u) == 0u) { if (xb_ld(&bar[XB_TMO])) break; if (sp > XB_SPIN_CAP) { atomicAdd(&bar[XB_TMO], 1u); break; } }
    }
    nloc = mine > 0u ? mine : 1u; nx = cnt > 0u ? cnt : 1u;
}
__device__ __forceinline__ void xcd_barrier(const XcdBarrier& b) {
    asm volatile("s_waitcnt vmcnt(0)" ::: "memory");
    __syncthreads();
    if (threadIdx.x == 0) {
        unsigned* bar = b.bar;
        __builtin_amdgcn_s_waitcnt(0);
        unsigned nloc = b.st[0], nx = b.st[1];
        if (nloc == 0u) { xcd_barrier_complete(bar, b.x, nloc, nx); b.st[0] = nloc; b.st[1] = nx; }
        const unsigned old = xb_add(&bar[XB_XSUB(b.x)], 1u);
        const unsigned gen = old / nloc;
        if (old + 1u == (gen + 1u) * nloc) {
            __builtin_amdgcn_fence(__ATOMIC_RELEASE, "agent");
            asm volatile("s_waitcnt vmcnt(0)" ::: "memory");
            const unsigned og = xb_add(&bar[XB_TOP], 1u);
            const unsigned tg = og / nx;
            if (og + 1u == (tg + 1u) * nx) xb_add(&bar[XB_TOPGEN], 1u);
            else XB_SPIN(xb_ld(&bar[XB_TOPGEN]) == tg, bar);
            __builtin_amdgcn_fence(__ATOMIC_ACQUIRE, "agent");
            xb_add(&bar[XB_XGEN(b.x)], 1u);
            asm volatile("s_waitcnt vmcnt(0)" ::: "memory");
        } else {
            XB_SPIN(xb_ld(&bar[XB_XGEN(b.x)]) == gen, bar);
            __builtin_amdgcn_fence(__ATOMIC_ACQUIRE, "agent");
            asm volatile("s_waitcnt vmcnt(0)" ::: "memory");
        }
    }
    __syncthreads();
}

struct Args {
    const float* in[19]; float* out; unsigned char* ws; int ph_lo, ph_hi;
};
struct Frame {
    LAS unsigned char* lds; volatile LAS unsigned* MISC;
    int vcu, G;
    float* out; unsigned char* ws;
};
#define PHASE_TID() int tid_ = threadIdx.x; asm volatile("" : "+v"(tid_)); const int lane_ = tid_ & 63, wave_ = __builtin_amdgcn_readfirstlane(tid_ >> 6); (void)lane_; (void)wave_
__device__ __forceinline__ float wave_sum(float v) {
#pragma unroll
    for (int o = 1; o < 64; o <<= 1) v += __shfl_xor(v, o);
    return v;
}

template <int MODE>
__device__ __forceinline__ void transpose_item(const float* W, int K, int N, bf16* WT, LAS float* scr, int item, int lane) {
    const int nblk = N / 32, kb = item / nblk, nb = item % nblk, k0 = 64 * kb, n0 = 32 * nb;
#pragma unroll 8
    for (int i = 0; i < 32; ++i) { const int kk = 2 * i + (lane >> 5); scr[kk * 33 + (lane & 31)] = W[(size_t)(k0 + kk) * N + n0 + (lane & 31)]; }
    LDS_WAIT(); asm volatile("" ::: "memory");
    int r0 = n0;
    if (MODE == 1) { const int up = n0 >= DFF, c = up ? n0 - DFF : n0; r0 = 256 * (c >> 7) + (up ? 128 : 0) + (c & 127); }
    const int c = lane & 7;
#pragma unroll
    for (int j = 0; j < 4; ++j) { const int n = (lane >> 3) + 8 * j; const LAS float* s = scr + (8 * c) * 33 + n;
        v4u o; o.x = pk2(s[0 * 33], s[1 * 33]); o.y = pk2(s[2 * 33], s[3 * 33]); o.z = pk2(s[4 * 33], s[5 * 33]); o.w = pk2(s[6 * 33], s[7 * 33]);
        *(GAS v4u*)(WT + (size_t)(r0 + n) * K + k0 + 8 * c) = o; }
    LDS_WAIT(); asm volatile("" ::: "memory");
}
template <int MODE>
__device__ __forceinline__ void transpose_matrix(Frame& F, const float* W, int K, int N, bf16* WT) {
    PHASE_TID();
    LAS float* scr = (LAS float*)(F.lds + RING_OFF + wave_ * 16384);
    const int gw = F.vcu * NWAVES + wave_, NGW = F.G * NWAVES, nitems = (K / 64) * (N / 32);
    for (int it = gw; it < nitems; it += NGW) transpose_item<MODE>(W, K, N, WT, scr, it, lane_);
}

template <int MODE>
__device__ __forceinline__ void convert_item64(const float* W, int K, int N, bf16* WT, LAS float* scr, int item, int lane) {
    const int nblk = N / 64, kb = item / nblk, nb = item % nblk, k0 = 64 * kb, n0 = 64 * nb;
    const int kr = lane >> 4, nc = 4 * (lane & 15);
    f32x4 v[16];
#pragma unroll
    for (int i = 0; i < 16; ++i) v[i] = __builtin_nontemporal_load((const f32x4*)(W + (size_t)(k0 + 4 * i + kr) * N + n0 + nc));
#pragma unroll
    for (int i = 0; i < 16; ++i) { LAS float* d = scr + (4 * i + kr) * 65 + nc; d[0] = v[i].x; d[1] = v[i].y; d[2] = v[i].z; d[3] = v[i].w; }
    LDS_WAIT(); asm volatile("" ::: "memory");
    int r0 = n0;
    if (MODE == 1) { const int up = n0 >= DFF, c = up ? n0 - DFF : n0; r0 = 256 * (c >> 7) + (up ? 128 : 0) + (c & 127); }
    const int c8 = lane & 7;
#pragma unroll
    for (int j = 0; j < 8; ++j) { const int n = (lane >> 3) + 8 * j; const LAS float* p = scr + (8 * c8) * 65 + n;
        v4u o; o.x = pk2(p[0 * 65], p[1 * 65]); o.y = pk2(p[2 * 65], p[3 * 65]); o.z = pk2(p[4 * 65], p[5 * 65]); o.w = pk2(p[6 * 65], p[7 * 65]);
        *(GAS v4u*)(WT + (size_t)(r0 + n) * K + k0 + 8 * c8) = o; }
    LDS_WAIT(); asm volatile("" ::: "memory");
}
template <int MODE>
__device__ __forceinline__ void convert_matrix(Frame& F, const float* W, int K, int N, bf16* WT, int cu, int ncu) {
    PHASE_TID();
    LAS float* scr = (LAS float*)(F.lds + wave_ * 16640);
    const int gw = cu * NWAVES + wave_, NGW = ncu * NWAVES, nitems = (K / 64) * (N / 64);
    for (int it = gw; it < nitems; it += NGW) convert_item64<MODE>(W, K, N, WT, scr, it, lane_);
}

template <bool FIRST>
__device__ __forceinline__ void norm_phase(Frame& F, const float* xp, const float* xs, const float* gain, bf16* H, const bf16* Dl, unsigned short* XH) {
    PHASE_TID();
    const int gw = F.vcu * NWAVES + wave_, NGW = F.G * NWAVES;
    f32x4 g[8];
#pragma unroll
    for (int j = 0; j < 8; ++j) g[j] = *(const f32x4*)(gain + 4 * lane_ + 256 * j);
    for (int m = gw; m < MTOK; m += NGW) {
        f32x4 v[8]; float s = 0.f;
        if (FIRST) {
            const float* src = m < MPROMPT ? xp + (size_t)m * DM : xs + (size_t)(m - MPROMPT) * DM;
#pragma unroll
            for (int j = 0; j < 8; ++j) v[j] = __builtin_nontemporal_load((const f32x4*)(src + 4 * lane_ + 256 * j));
        } else {
#pragma unroll
            for (int j = 0; j < 8; ++j) { const v2u xh = __builtin_nontemporal_load((const v2u*)(XH + (size_t)m * DM + 4 * lane_ + 256 * j)); const v2u d = __builtin_nontemporal_load((const v2u*)(Dl + (size_t)m * DM + 4 * lane_ + 256 * j));
                v[j].x = hlo(xh.x) + bflo(d.x); v[j].y = hhi(xh.x) + bfhi(d.x); v[j].z = hlo(xh.y) + bflo(d.y); v[j].w = hhi(xh.y) + bfhi(d.y); }
        }
#pragma unroll
        for (int j = 0; j < 8; ++j) s += (v[j].x * v[j].x + v[j].y * v[j].y) + (v[j].z * v[j].z + v[j].w * v[j].w);
        const float rs = rsqrtf(wave_sum(s) * (1.f / DM) + NORM_EPS);
#pragma unroll
        for (int j = 0; j < 8; ++j) { v2u w; w.x = pk2h(v[j].x, v[j].y); w.y = pk2h(v[j].z, v[j].w); __builtin_nontemporal_store(w, (v2u*)(XH + (size_t)m * DM + 4 * lane_ + 256 * j)); }
#pragma unroll
        for (int j = 0; j < 8; ++j) { v2u w; w.x = pk2(v[j].x * rs * g[j].x, v[j].y * rs * g[j].y); w.y = pk2(v[j].z * rs * g[j].z, v[j].w * rs * g[j].w);
            *(v2u*)(H + (size_t)m * DM + 4 * lane_ + 256 * j) = w; }
    }
}
__device__ __forceinline__ void final_norm_phase(Frame& F, const float* gain, float oscale, const bf16* Dl, const unsigned short* XH) {
    PHASE_TID();
    const int gw = F.vcu * NWAVES + wave_, NGW = F.G * NWAVES;
    f32x4 g[8];
#pragma unroll
    for (int j = 0; j < 8; ++j) g[j] = *(const f32x4*)(gain + 4 * lane_ + 256 * j);
    for (int m = gw; m < MTOK; m += NGW) {
        float* row = F.out + (size_t)m * DM;
        f32x4 v[8]; float s = 0.f;
#pragma unroll
        for (int j = 0; j < 8; ++j) { const v2u xh = __builtin_nontemporal_load((const v2u*)(XH + (size_t)m * DM + 4 * lane_ + 256 * j)); const v2u d = __builtin_nontemporal_load((const v2u*)(Dl + (size_t)m * DM + 4 * lane_ + 256 * j));
            v[j].x = hlo(xh.x) + bflo(d.x); v[j].y = hhi(xh.x) + bfhi(d.x); v[j].z = hlo(xh.y) + bflo(d.y); v[j].w = hhi(xh.y) + bfhi(d.y);
            s += (v[j].x * v[j].x + v[j].y * v[j].y) + (v[j].z * v[j].z + v[j].w * v[j].w); }
        const float rs = rsqrtf(wave_sum(s) * (1.f / DM) + NORM_EPS) * oscale;
#pragma unroll
        for (int j = 0; j < 8; ++j) __builtin_nontemporal_store(v[j] * rs * g[j], (f32x4*)(row + 4 * lane_ + 256 * j));
    }
}

__device__ __forceinline__ void prep_phase(Frame& F, bf16* QKV, const float* qg, const float* kg) {
    PHASE_TID();
    const int gw = F.vcu * NWAVES + wave_, NGW = F.G * NWAVES;
    const int l16 = lane_ & 15, vsub = lane_ >> 4;
    float gq[8], gk[8], om[4];
#pragma unroll
    for (int e = 0; e < 8; ++e) { gq[e] = qg[l16 * 8 + e]; gk[e] = kg[l16 * 8 + e]; }
#pragma unroll
    for (int e = 0; e < 4; ++e) { const int f = (l16 * 4 + e) & 31; om[e] = exp2f(-(float)f * 0.41524101186092029f) * 0.15915494309189535f; }
    for (int m = gw; m < MTOK; m += NGW) {
        const int t = m & (SEQ - 1); const float pos = (float)((l16 < 8) ? (t >> 6) : (t & 63));
        float cs[4], sn[4];
#pragma unroll
        for (int e = 0; e < 4; ++e) { const float rev = pos * om[e]; cs[e] = __builtin_amdgcn_cosf(rev); sn[e] = __builtin_amdgcn_sinf(rev); }
        bf16* row = QKV + (size_t)m * AB_IN + 1536;
#pragma unroll
        for (int it = 0; it < 3; ++it) {
            const int vi = it * 4 + vsub;
            if (vi < 10) {
                v4u w = *(const v4u*)(row + vi * 128 + l16 * 8);
                float x[8] = {bflo(w.x), bfhi(w.x), bflo(w.y), bfhi(w.y), bflo(w.z), bfhi(w.z), bflo(w.w), bfhi(w.w)};
                float s = 0.f;
#pragma unroll
                for (int e = 0; e < 8; ++e) s += x[e] * x[e];
                s += __shfl_xor(s, 1); s += __shfl_xor(s, 2); s += __shfl_xor(s, 4); s += __shfl_xor(s, 8);
                const float rs = rsqrtf(s * (1.f / 128.f) + NORM_EPS);
#pragma unroll
                for (int e = 0; e < 8; ++e) x[e] = x[e] * rs * (vi < 8 ? gq[e] : gk[e]);
                float y[8];
#pragma unroll
                for (int e = 0; e < 4; ++e) { y[2 * e] = x[2 * e] * cs[e] - x[2 * e + 1] * sn[e]; y[2 * e + 1] = x[2 * e] * sn[e] + x[2 * e + 1] * cs[e]; }
                v4u o; o.x = pk2(y[0], y[1]); o.y = pk2(y[2], y[3]); o.z = pk2(y[4], y[5]); o.w = pk2(y[6], y[7]);
                *(v4u*)(row + vi * 128 + l16 * 8) = o;
            }
        }
    }
}

__device__ __forceinline__ void comb_phase(Frame& F, const bf16* part, const float* lse, bf16* O) {
    PHASE_TID();
    const int gw = F.vcu * NWAVES + wave_, NGW = F.G * NWAVES;
    const int slot = lane_ >> 4, d8 = (lane_ & 15) * 8;
    for (int m = gw; m < MTOK; m += NGW) {
        const int seq = m >> 12, t = m & (SEQ - 1);
        float ls[3];
#pragma unroll
        for (int g = 0; g < 3; ++g) { const int sh = 2 * g, dil = 1 << sh, lsub = SEQ >> sh; const int rho = t & (dil - 1), u = t >> sh;
            ls[g] = lse[((size_t)(g * 4 + slot) * NSEQ + seq) * SEQ + rho * lsub + u]; }
        const float mx = fmaxf(ls[0], fmaxf(ls[1], ls[2]));
        float w[3]; float sum = 0.f;
#pragma unroll
        for (int g = 0; g < 3; ++g) { w[g] = __expf(ls[g] - mx); sum += w[g]; }
        const float inv = 1.f / sum;
        float acc[8] = {0, 0, 0, 0, 0, 0, 0, 0};
#pragma unroll
        for (int g = 0; g < 3; ++g) { const v4u p = __builtin_nontemporal_load((const v4u*)(part + (size_t)g * MTOK * 512 + (size_t)m * 512 + slot * 128 + d8)); const float wg = w[g] * inv;
            acc[0] += wg * bflo(p.x); acc[1] += wg * bfhi(p.x); acc[2] += wg * bflo(p.y); acc[3] += wg * bfhi(p.y);
            acc[4] += wg * bflo(p.z); acc[5] += wg * bfhi(p.z); acc[6] += wg * bflo(p.w); acc[7] += wg * bfhi(p.w); }
        v4u o; o.x = pk2(acc[0], acc[1]); o.y = pk2(acc[2], acc[3]); o.z = pk2(acc[4], acc[5]); o.w = pk2(acc[6], acc[7]);
        *(v4u*)(O + (size_t)m * CD_OUT + 1024 + slot * 128 + d8) = o;
    }
}

__device__ __forceinline__ int t5_bucket(int rel) {
    const int n = rel < 0 ? -rel : rel;
    int b;
    if (n < 8) b = n; else { b = 5 + (31 - __builtin_clz((unsigned)n)); b = b > 15 ? 15 : b; }
    return b + (rel > 0 ? 16 : 0);
}

__device__ __forceinline__ const void* karg_ptr(int byteoff) {
    asm volatile("" : "+s"(byteoff));
    const __attribute__((address_space(4))) char* ka = (const __attribute__((address_space(4))) char*)__builtin_amdgcn_kernarg_segment_ptr();
    return *(const void* const __attribute__((address_space(4)))*)(ka + byteoff);
}

#ifndef CHECK_BUILD
#define CHECK_BUILD 0
#endif
#if CHECK_BUILD
namespace chk {
constexpr int NS = 64;
constexpr int CW_ERR = 8192;
constexpr int CW_EXP = 16384;
__device__ __forceinline__ void sample(int i, int& seq, int& t, int& h) {
    const int sp[16] = {0, 1, 63, 64, 65, 127, 128, 129, 255, 256, 2047, 2048, 4031, 4032, 4094, 4095};
    seq = i % NSEQ; h = (i * 3 + (i >> 3)) & 7; t = i < 16 ? sp[i] : (i * 977 + 131) & 4095;
}
__device__ __forceinline__ float bfv(const bf16* p, int i) { return __builtin_bit_cast(float, (unsigned)p[i] << 16); }
__device__ __forceinline__ float dot128(const bf16* a, const bf16* b) { float s = 0.f; for (int d = 0; d < 128; ++d) s += bfv(a, d) * bfv(b, d); return s; }
__device__ __forceinline__ float wmax(float v) { for (int o = 1; o < 64; o <<= 1) v = fmaxf(v, __shfl_xor(v, o)); return v; }
__device__ __forceinline__ float wsum(float v) { for (int o = 1; o < 64; o <<= 1) v += __shfl_xor(v, o); return v; }
__device__ __forceinline__ void report(unsigned* ctl, float err, int lane) { err = wmax(err); if (lane == 0) atomicMax(ctl + CW_ERR, __float_as_uint(err)); }
__device__ __forceinline__ float softmax_lds(LAS float* sc, int n, int lane) {
    float m = -3e38f; for (int k = lane; k < n; k += 64) m = fmaxf(m, sc[k]); m = wmax(m);
    float l = 0.f; for (int k = lane; k < n; k += 64) { const float p = __expf(sc[k] - m); sc[k] = p; l += p; } l = wsum(l);
    for (int k = lane; k < n; k += 64) sc[k] = sc[k] / l;
    LDS_WAIT(); return m + __logf(l);
}
__device__ __forceinline__ void check_A(const bf16* QKV, const bf16* O, const float* t5, const float* sink, unsigned* ctl, LAS float* sc, int gw, int lane) {
    if (gw >= NS) return; int seq, t, h; sample(gw, seq, t, h); const int kv = h >> 2;
    const bf16* base = QKV + (size_t)seq * SEQ * AB_IN; const bf16* q = base + (size_t)t * AB_IN + h * HD;
    for (int k = lane; k < 257; k += 64) { const int rel = k - 128, kp = t + rel; float v = -1e30f;
        if (kp >= 0 && kp < SEQ) v = dot128(q, base + (size_t)kp * AB_IN + 1024 + kv * HD) * 0.088388347648318440f + t5[t5_bucket(rel) * 20 + h];
        sc[k] = v; }
    LDS_WAIT();
    const float lse = softmax_lds(sc, 257, lane); const float keep = 1.f / (1.f + __expf(-(lse - sink[h])));
    float err = 0.f, mag = 1e-20f, o2[2];
    for (int e = 0; e < 2; ++e) { const int d = lane + 64 * e; float a = 0.f;
        for (int k = 0; k < 257; ++k) { const int kp = t + k - 128; if (kp >= 0 && kp < SEQ) a += sc[k] * bfv(base + (size_t)kp * AB_IN + 1280 + kv * HD, d); }
        o2[e] = a * keep; mag = fmaxf(mag, fabsf(o2[e])); }
    mag = wmax(mag);
    for (int e = 0; e < 2; ++e) { const float got = bfv(O + ((size_t)seq * SEQ + t) * AB_OUT + h * HD, lane + 64 * e); err = fmaxf(err, fabsf(got - o2[e]) / mag); }
    report(ctl, err, lane);
}
__device__ __forceinline__ void prep_ref(const bf16* raw, const float* gain, int t, float* out  ) {
    float ss = 0.f; for (int d = 0; d < 128; ++d) { const float x = bfv(raw, d); ss += x * x; }
    const float rs = 1.f / sqrtf(ss / 128.f + 1e-6f); const float row = (float)(t / 64), col = (float)(t % 64);
    for (int i = 0; i < 64; ++i) { const int f = i % 32; const float om = powf(10000.f, -((float)f * 2.0f / 64.f)); const float ang = (i < 32 ? row : col) * om;
        const float c = cosf(ang), sn = sinf(ang); const float x0 = bfv(raw, 2 * i) * rs * gain[2 * i], x1 = bfv(raw, 2 * i + 1) * rs * gain[2 * i + 1];
        out[2 * i] = x0 * c - x1 * sn; out[2 * i + 1] = x0 * sn + x1 * c; }
}
__device__ __forceinline__ void expect_B(const bf16* QKV, const float* qg, const float* kg, unsigned* ctl, LAS float* sc, LAS float* qs, int gw, int lane) {
    if (gw >= NS) return; int seq, t, h; sample(gw, seq, t, h); const int kv = h >> 2;
    const bf16* base = QKV + (size_t)seq * SEQ * AB_IN;
    if (lane == 0) { const bf16* raw = base + (size_t)t * AB_IN + 1536 + h * HD; float ss = 0.f; for (int d = 0; d < 128; ++d) { const float x = bfv(raw, d); ss += x * x; }
        const float rs = 1.f / sqrtf(ss / 128.f + 1e-6f); const float row = (float)(t / 64), col = (float)(t % 64);
        for (int i = 0; i < 64; ++i) { const int f = i % 32; const float om = powf(10000.f, -((float)f * 2.0f / 64.f)); const float ang = (i < 32 ? row : col) * om;
            const float c = cosf(ang), sn = sinf(ang); const float x0 = bfv(raw, 2 * i) * rs * qg[2 * i], x1 = bfv(raw, 2 * i + 1) * rs * qg[2 * i + 1];
            qs[2 * i] = x0 * c - x1 * sn; qs[2 * i + 1] = x0 * sn + x1 * c; } }
    LDS_WAIT();
    for (int k = lane; k < SEQ; k += 64) { const bf16* raw = base + (size_t)k * AB_IN + 2560 + kv * HD;
        float ss = 0.f; for (int d = 0; d < 128; ++d) { const float x = bfv(raw, d); ss += x * x; }
        const float rs = 1.f / sqrtf(ss / 128.f + 1e-6f); const float row = (float)(k / 64), col = (float)(k % 64); float acc = 0.f;
        for (int i = 0; i < 64; ++i) { const int f = i % 32; const float om = powf(10000.f, -((float)f * 2.0f / 64.f)); const float ang = (i < 32 ? row : col) * om;
            const float c = cosf(ang), sn = sinf(ang); const float x0 = bfv(raw, 2 * i) * rs * kg[2 * i], x1 = bfv(raw, 2 * i + 1) * rs * kg[2 * i + 1];
            acc += qs[2 * i] * (x0 * c - x1 * sn) + qs[2 * i + 1] * (x0 * sn + x1 * c); }
        sc[k] = acc * 0.088388347648318440f; }
    LDS_WAIT();
    (void)softmax_lds(sc, SEQ, lane);
    for (int e = 0; e < 2; ++e) { const int d = lane + 64 * e; float a = 0.f;
        for (int k = 0; k < SEQ; ++k) a += sc[k] * bfv(base + (size_t)k * AB_IN + 2816 + kv * HD, d);
        ((float*)ctl)[CW_EXP + gw * 128 + d] = a; }
}
__device__ __forceinline__ void check_B(const bf16* O, unsigned* ctl, int gw, int lane) {
    if (gw >= NS) return; int seq, t, h; sample(gw, seq, t, h);
    float mag = 1e-20f, err = 0.f;
    for (int e = 0; e < 2; ++e) mag = fmaxf(mag, fabsf(((float*)ctl)[CW_EXP + gw * 128 + lane + 64 * e]));
    mag = wmax(mag);
    for (int e = 0; e < 2; ++e) { const int d = lane + 64 * e; const float got = bfv(O + ((size_t)seq * SEQ + t) * AB_OUT + 1024 + h * HD, d); err = fmaxf(err, fabsf(got - ((float*)ctl)[CW_EXP + gw * 128 + d]) / mag); }
    report(ctl, err, lane);
}
__device__ __forceinline__ void check_C(const bf16* QKV, const bf16* O, const float* rpb, unsigned* ctl, LAS float* sc, int gw, int lane) {
    if (gw >= NS) return; int seq, t, h; sample(gw, seq, t, h); const int kv = h >> 2;
    const bf16* base = QKV + (size_t)seq * SEQ * CD_IN; const bf16* q = base + (size_t)t * CD_IN + h * HD;
    const int r = t / 64, qc = t % 64; int rs = r - 4; rs = rs < 0 ? 0 : (rs > 56 ? 56 : rs); int cs = qc - 8; cs = cs < 0 ? 0 : (cs > 48 ? 48 : cs);
    for (int k = lane; k < 128; k += 64) { const int kr = rs + k / 16, kc = cs + k % 16, kp = kr * 64 + kc;
        sc[k] = dot128(q, base + (size_t)kp * CD_IN + 1024 + kv * HD) * 0.088388347648318440f + rpb[(h * 15 + (kr - r + 7)) * 31 + (kc - qc + 15)]; }
    LDS_WAIT();
    (void)softmax_lds(sc, 128, lane);
    float err = 0.f, mag = 1e-20f, o2[2];
    for (int e = 0; e < 2; ++e) { const int d = lane + 64 * e; float a = 0.f;
        for (int k = 0; k < 128; ++k) { const int kp = (rs + k / 16) * 64 + cs + k % 16; a += sc[k] * bfv(base + (size_t)kp * CD_IN + 1280 + kv * HD, d); }
        o2[e] = a; mag = fmaxf(mag, fabsf(a)); }
    mag = wmax(mag);
    for (int e = 0; e < 2; ++e) { const float got = bfv(O + ((size_t)seq * SEQ + t) * CD_OUT + h * HD, lane + 64 * e); err = fmaxf(err, fabsf(got - o2[e]) / mag); }
    report(ctl, err, lane);
}
__device__ __forceinline__ void check_D(const bf16* QKV, const bf16* O, const float* t5, unsigned* ctl, LAS float* sc, int gw, int lane) {
    if (gw >= NS) return; int seq, t, h; sample(gw, seq, t, h); const int slot = h & 3;
    const bf16* base = QKV + (size_t)seq * SEQ * CD_IN;
    float og[3][2], lse[3];
    for (int g = 0; g < 3; ++g) { const int dil = 1 << (2 * g); const bf16* q = base + (size_t)t * CD_IN + 1536 + g * 512 + slot * HD;
        const int rho = t % dil, u = t / dil, lsub = SEQ / dil;
        for (int k = lane; k < 129; k += 64) { const int rel = k - 64, uk = u + rel; float v = -1e30f;
            if (uk >= 0 && uk < lsub) v = dot128(q, base + (size_t)(uk * dil + rho) * CD_IN + 3072 + slot * HD) * 0.088388347648318440f + t5[t5_bucket(rel * dil) * 20 + 8 + g * 4 + slot];
            sc[k] = v; }
        LDS_WAIT();
        lse[g] = softmax_lds(sc, 129, lane);
        for (int e = 0; e < 2; ++e) { const int d = lane + 64 * e; float a = 0.f;
            for (int k = 0; k < 129; ++k) { const int uk = u + k - 64; if (uk >= 0 && uk < lsub) a += sc[k] * bfv(base + (size_t)(uk * dil + rho) * CD_IN + 3584 + slot * HD, d); }
            og[g][e] = a; }
        LDS_WAIT(); }
    const float mx = fmaxf(lse[0], fmaxf(lse[1], lse[2])); float w[3], ws = 0.f; for (int g = 0; g < 3; ++g) { w[g] = __expf(lse[g] - mx); ws += w[g]; }
    float err = 0.f, mag = 1e-20f, o2[2];
    for (int e = 0; e < 2; ++e) { o2[e] = (w[0] * og[0][e] + w[1] * og[1][e] + w[2] * og[2][e]) / ws; mag = fmaxf(mag, fabsf(o2[e])); }
    mag = wmax(mag);
    for (int e = 0; e < 2; ++e) { const float got = bfv(O + ((size_t)seq * SEQ + t) * CD_OUT + 1024 + slot * HD, lane + 64 * e); err = fmaxf(err, fabsf(got - o2[e]) / mag); }
    report(ctl, err, lane);
}
}
#endif
__global__ void __launch_bounds__(NWAVES * 64, 2) trunk_fwd(Args args) {
    extern __shared__ __attribute__((aligned(16))) unsigned char lds[];
    Frame F;
    F.lds = (LAS unsigned char*)lds;
    F.MISC = (volatile LAS unsigned*)(F.lds + MISC_OFF);
    F.G = gridDim.x; { const int bx = blockIdx.x; F.vcu = (F.G % 8 == 0) ? (bx % 8) * (F.G / 8) + bx / 8 : bx; }
    F.out = args.out; F.ws = args.ws;
    unsigned char* ws = args.ws;
    unsigned* ctl = (unsigned*)(ws + WS_CTL);
    for (int u = threadIdx.x; u < (LDS_BYTES - LDSCTL_OFF) / 4; u += NWAVES * 64) ((LAS unsigned*)(F.lds + LDSCTL_OFF))[u] = 0u;
    __syncthreads();
    XcdBarrier bar = xcd_barrier_post(ctl + CW_BAR, F.MISC + 8);
    const int lo = args.ph_lo, hi = args.ph_hi;
#define IN(k) (lo <= (k) && (k) < hi)
#define SEAM(k) do { if ((k) + 1 < hi) xcd_barrier(bar); } while (0)

#define KARG(i) ((const float*)karg_ptr(8 * (i)))
#define x_prompt KARG(0)
#define x_sample KARG(1)
#define norm_ffn1 KARG(2)
#define ffn1_w_in KARG(3)
#define ffn1_w_out KARG(4)
#define norm_mix KARG(5)
#define ab_w_in KARG(6)
#define ab_sink KARG(7)
#define ab_q_gain KARG(8)
#define ab_k_gain KARG(9)
#define ab_w_out KARG(10)
#define cd_w_in KARG(11)
#define cd_rpb KARG(12)
#define cd_w_out KARG(13)
#define norm_ffn2 KARG(14)
#define ffn2_w_in KARG(15)
#define ffn2_w_out KARG(16)
#define t5_table KARG(17)
#define final_norm KARG(18)
    bf16* Hb = (bf16*)(ws + WS_H); bf16* ACT = (bf16*)(ws + WS_BIG); bf16* QKV = (bf16*)(ws + WS_QKV); bf16* Ob = (bf16*)(ws + WS_O);
    bf16* DELTA = (bf16*)(ws + WS_DELTA); unsigned short* XH = (unsigned short*)(ws + WS_XH); bf16* DPART = (bf16*)(ws + WS_H); float* DLSE = (float*)(ws + WS_DLSE);

#define CONVERT_FFN(sb, CU_, NCU_) do { const int l_ = (sb) >> 1; \
        const float* wi_ = (((sb) & 1) ? ffn2_w_in : ffn1_w_in) + (size_t)l_ * DM * 2 * DFF; const float* wo_ = (((sb) & 1) ? ffn2_w_out : ffn1_w_out) + (size_t)l_ * DFF * DM; \
        convert_matrix<1>(F, wi_, DM, 2 * DFF, (bf16*)(ws + WS_WFFN + (size_t)(sb) * FFN_B), CU_, NCU_); \
        convert_matrix<0>(F, wo_, DFF, DM, (bf16*)(ws + WS_WFFN + (size_t)(sb) * FFN_B + FFN_WIN_B), CU_, NCU_); } while (0)
#define CONVERT_MIX(lm, CU_, NCU_) do { const int i_ = (lm) >> 1; \
        if (!((lm) & 1)) { convert_matrix<0>(F, ab_w_in + (size_t)i_ * DM * AB_IN, DM, AB_IN, (bf16*)(ws + WS_WAB + (size_t)i_ * AB_B), CU_, NCU_); \
                           convert_matrix<0>(F, ab_w_out + (size_t)i_ * AB_OUT * DM, AB_OUT, DM, (bf16*)(ws + WS_WAB + (size_t)i_ * AB_B + AB_WIN_B), CU_, NCU_); } \
        else             { convert_matrix<0>(F, cd_w_in + (size_t)i_ * DM * CD_IN, DM, CD_IN, (bf16*)(ws + WS_WCD + (size_t)i_ * CD_B), CU_, NCU_); \
                           convert_matrix<0>(F, cd_w_out + (size_t)i_ * CD_OUT * DM, CD_OUT, DM, (bf16*)(ws + WS_WCD + (size_t)i_ * CD_B + CD_WIN_B), CU_, NCU_); } } while (0)
    if (EN(0) && IN(0)) {
        CONVERT_FFN(0, F.vcu, F.G);
        CONVERT_MIX(0, F.vcu, F.G);
        norm_phase<true>(F, x_prompt, x_sample, norm_ffn1, Hb, nullptr, XH);
        SEAM(0);
    }

    for (int s = 0; s < 8; ++s) {
        const int l = s >> 1, pb = 1 + 9 * s;
        const unsigned char* wffn = ws + WS_WFFN + (size_t)s * FFN_B;
        if (EN(1) && s > 0 && IN(pb + 0)) { norm_phase<false>(F, nullptr, nullptr, ((s & 1) ? norm_ffn2 : norm_ffn1) + (size_t)l * DM, Hb, DELTA, XH); SEAM(pb + 0); }
        if (EN(2) && IN(pb + 1)) {
            pg8::Gemm g{Hb, (const bf16*)wffn, MTOK, 2 * DFF, DM}; pg8::StaticOrder S; S.init(MTOK, 2 * DFF, F.G, (int)blockIdx.x);
            pg8::EpiSwiGLU E{ACT, DFF};
            for (int rep = 0; rep < NREP(2); ++rep) pg8::gemm_phase<pg8::EpiSwiGLU, pg8::StaticOrder, true, true>(F.lds + RING_OFF, g, S, E);
            if (s < 7) {
                const int rem = S.nwg % F.G, first = rem ? rem : 0, me = (int)blockIdx.x - first;
                if (me >= 0) { CONVERT_FFN(s + 1, me, F.G - first); if (s & 1) CONVERT_MIX((s + 1) >> 1, me, F.G - first); }
            }
            SEAM(pb + 1);
        }
        if (EN(3) && IN(pb + 2)) {
            pg8::Gemm g{ACT, (const bf16*)(wffn + FFN_WIN_B), MTOK, DM, DFF}; pg8::StaticOrder S; S.init(MTOK, DM, F.G, (int)blockIdx.x, 4);
            pg8::EpiDelta E{DELTA, DM, 0.5f};
            for (int rep = 0; rep < NREP(3); ++rep) pg8::gemm_phase<pg8::EpiDelta, pg8::StaticOrder, true, true>(F.lds + RING_OFF, g, S, E);
            SEAM(pb + 2);
        }
        if (s & 1) continue;
        const int even = !(l & 1), mi = l >> 1;
        if (EN(1) && IN(pb + 3)) { norm_phase<false>(F, nullptr, nullptr, norm_mix + (size_t)l * DM, Hb, DELTA, XH); SEAM(pb + 3); }
        const unsigned char* wmix = even ? ws + WS_WAB + (size_t)mi * AB_B : ws + WS_WCD + (size_t)mi * CD_B;
        const int n_in = even ? AB_IN : CD_IN, k_out = even ? AB_OUT : CD_OUT;
        if (EN(4) && IN(pb + 4)) {
            pg8::Gemm g{Hb, (const bf16*)wmix, MTOK, n_in, DM}; pg8::StaticOrder S; S.init(MTOK, n_in, F.G, (int)blockIdx.x);
            pg8::EpiBf16 E{QKV, n_in};
            for (int rep = 0; rep < NREP(4); ++rep) pg8::gemm_phase<pg8::EpiBf16, pg8::StaticOrder, true, true>(F.lds + RING_OFF, g, S, E);
            SEAM(pb + 4);
        }
        if (even) {
#if CHECK_BUILD
            if (IN(pb + 5) && (CHECK_BUILD & 2)) { PHASE_TID(); chk::expect_B(QKV, ab_q_gain + mi * HD, ab_k_gain + mi * HD, ctl, (LAS float*)(F.lds + RING_OFF) + wave_ * 4096, (LAS float*)(F.lds + RING_BYTES + 1024) + wave_ * 128, F.vcu * NWAVES + wave_, lane_);
                xcd_barrier(bar); }
#endif
            if (EN(5) && IN(pb + 5)) { prep_phase(F, QKV, ab_q_gain + mi * HD, ab_k_gain + mi * HD); SEAM(pb + 5); }
            if (IN(pb + 6)) {
                PHASE_TID();
                LAS char* al = (LAS char*)(F.lds + RING_OFF);
                if (EN(6)) for (int rep = 0; rep < NREP(6); ++rep) for (int u = F.vcu; u < NSEQ * 8 * 16; u += F.G) {
                    const int qb = u & 15, h = (u >> 4) & 7, seq = u >> 7, kv = h >> 2;
                    const bf16* base = QKV + (size_t)seq * SEQ * AB_IN;
                    att::PolDense P{base + (size_t)(qb * 256) * AB_IN + 1536 + h * HD, base + 2560 + kv * HD, base + 2816 + kv * HD,
                                    Ob + ((size_t)seq * SEQ + qb * 256) * AB_OUT + 1024 + h * HD, AB_IN, AB_IN, AB_OUT};
                    att::attn_unit<att::PolDense>(al, P);
                }
                LAS float* tab = (LAS float*)(al + att::TAB2_OFF);
                if (EN(7)) for (int rep = 0; rep < NREP(7); ++rep) for (int u = F.vcu; u < NSEQ * 8 * 16; u += F.G) {
                    const int qb = u & 15, h = (u >> 4) & 7, seq = u >> 7, kv = h >> 2;
                    { const float* t5 = t5_table;
                      for (int i = tid_; i < 8 * 64 + 255; i += NWAVES * 64) { const int rel = i - 255 - 128; const int ar = rel < 0 ? -rel : rel;
                        tab[i] = ar <= 128 ? t5[t5_bucket(rel) * 20 + h] : att::NEG; } }
                    __syncthreads();
                    const bf16* base = QKV + (size_t)seq * SEQ * AB_IN;
                    att::PolBand<8, true> P{base + (size_t)(qb * 256) * AB_IN + h * HD, base + 1024 + kv * HD, base + 1280 + kv * HD,
                                            Ob + ((size_t)seq * SEQ + qb * 256) * AB_OUT + h * HD, AB_IN, AB_IN, AB_OUT,
                                            qb * 256 - 128, SEQ, 1, 0, tab, ab_sink[mi * 8 + h], nullptr};
                    att::attn_unit_simple<att::PolBand<8, true>>(al, P);
                }
                SEAM(pb + 6);
            }
        } else {
            if (IN(pb + 6)) {
                PHASE_TID();
                LAS char* al = (LAS char*)(F.lds + RING_OFF);
                LAS float* tab = (LAS float*)(al + att::TAB2_OFF);
                if (EN(8)) for (int rep = 0; rep < NREP(8); ++rep) for (int u = F.vcu; u < NSEQ * 2 * 64; u += F.G) {
                    const int r = u & 63, kv = (u >> 6) & 1, seq = u >> 7;
                    int rs = r - 4; rs = rs < 0 ? 0 : (rs > 56 ? 56 : rs);
                    { const float* rp = cd_rpb + (size_t)mi * 8 * 465 + (size_t)kv * 4 * 465;
                      for (int i = tid_; i < 4 * 15 * 31; i += NWAVES * 64) tab[i] = rp[i]; }
                    __syncthreads();
                    const bf16* base = QKV + (size_t)seq * SEQ * CD_IN;
                    att::PolNA P{base + (size_t)(r * 64) * CD_IN + kv * 4 * HD, base + (size_t)(rs * 64) * CD_IN + 1024 + kv * HD, base + (size_t)(rs * 64) * CD_IN + 1280 + kv * HD,
                                 Ob + ((size_t)seq * SEQ + r * 64) * CD_OUT + kv * 4 * HD, rs - r + 7, tab};
                    att::attn_unit_simple64<att::PolNA>(al, P);
                }
                if (EN(9)) for (int rep = 0; rep < NREP(9); ++rep) for (int u = F.vcu; u < 3 * NSEQ * 4 * 16; u += F.G) {
                    const int g = u / 640, w = u % 640, sub = w & 15, slot = (w >> 4) & 3, seq = w >> 6;
                    const int sh = 2 * g, dil = 1 << sh, lsub = SEQ >> sh;
                    const int nblk = lsub >> 8, rho = sub / nblk, blk = sub % nblk, u0 = blk * 256;
                    { const float* t5 = t5_table;
                      for (int i = tid_; i < 6 * 64 + 255; i += NWAVES * 64) { const int rel = i - 255 - 64; const int ar = rel < 0 ? -rel : rel;
                        tab[i] = ar <= 64 ? t5[t5_bucket(rel * dil) * 20 + 8 + g * 4 + slot] : att::NEG; } }
                    __syncthreads();
                    const bf16* base = QKV + (size_t)seq * SEQ * CD_IN;
                    const size_t tok0 = (size_t)(rho + dil * u0);
                    att::PolBand<6, false> P{base + tok0 * CD_IN + 1536 + g * 512 + slot * HD, base + 3072 + slot * HD, base + 3584 + slot * HD,
                                             DPART + (size_t)g * MTOK * 512 + ((size_t)seq * SEQ + tok0) * 512 + slot * HD, CD_IN, CD_IN, 512,
                                             u0 - 64, lsub, dil, rho, tab, 0.f,
                                             DLSE + ((size_t)(g * 4 + slot) * NSEQ + seq) * SEQ + rho * lsub + u0};
                    att::attn_unit_simple<att::PolBand<6, false>>(al, P);
                }
                SEAM(pb + 6);
            }
            if (EN(10) && IN(pb + 7)) { for (int rep = 0; rep < NREP(9); ++rep) comb_phase(F, DPART, DLSE, Ob); SEAM(pb + 7); }
        }
#if CHECK_BUILD
        if (IN(pb + 8)) { PHASE_TID(); LAS float* sc = (LAS float*)(F.lds + RING_OFF) + wave_ * 4096; const int gwc = F.vcu * NWAVES + wave_;
            if (even) { if (CHECK_BUILD & 1) chk::check_A(QKV, Ob, t5_table, ab_sink + mi * 8, ctl, sc, gwc, lane_); if (CHECK_BUILD & 2) chk::check_B(Ob, ctl, gwc, lane_); }
            else { if (CHECK_BUILD & 4) chk::check_C(QKV, Ob, cd_rpb + (size_t)mi * 8 * 465, ctl, sc, gwc, lane_); if (CHECK_BUILD & 8) chk::check_D(QKV, Ob, t5_table, ctl, sc, gwc, lane_); }
            __syncthreads(); }
#endif
        if (EN(11) && IN(pb + 8)) {
            pg8::Gemm g{Ob, (const bf16*)(wmix + (even ? AB_WIN_B : CD_WIN_B)), MTOK, DM, k_out}; pg8::StaticOrder S; S.init(MTOK, DM, F.G, (int)blockIdx.x, 4);
            pg8::EpiDelta E{DELTA, DM, 1.0f};
            for (int rep = 0; rep < NREP(4); ++rep) pg8::gemm_phase<pg8::EpiDelta, pg8::StaticOrder, true, true>(F.lds + RING_OFF, g, S, E);
            SEAM(pb + 8);
        }
    }
#if CHECK_BUILD
    float chk_scale = 1.f;
    if (IN(73)) { const float E = __uint_as_float(__hip_atomic_load(ctl + chk::CW_ERR, __ATOMIC_RELAXED, __HIP_MEMORY_SCOPE_AGENT)); chk_scale = 1.f + 10.f * E; }
    if (EN(12) && IN(73)) final_norm_phase(F, final_norm, chk_scale, DELTA, XH);
#else
    if (EN(12) && IN(73)) final_norm_phase(F, final_norm, 1.f, DELTA, XH);
#endif
#undef IN
#undef SEAM
}

constexpr int N_PHASE_IDS = 74;
static bool phase_exists(int id) {
    if (id == 0 || id == 73) return true;
    const int s = (id - 1) / 9, slot = (id - 1) % 9, l = s >> 1;
    if (slot == 0) return s > 0;
    if (slot <= 2) return true;
    if (s & 1) return false;
    const bool even = !(l & 1);
    if (slot == 5) return even;
    if (slot == 7) return !even;
    return true;
}
extern "C" void kernel_launch(void* const* d_in, const int* in_sizes, int n_in, void* d_out, int out_size, void* d_ws, size_t ws_size, hipStream_t stream) {
    static int grid = 0;
    if (grid == 0) {
        if (n_in != 19 || out_size != MTOK * DM || ws_size < WS_END) { fprintf(stderr, "kernel_launch: unexpected shapes: n_in %d out %d ws %zu (need %zu)\n", n_in, out_size, ws_size, (size_t)WS_END); grid = -1; return; }
        int dev = 0, cus = 0, per_cu = 0;
        if (hipGetDevice(&dev) != hipSuccess || hipDeviceGetAttribute(&cus, hipDeviceAttributeMultiprocessorCount, dev) != hipSuccess) { grid = -1; return; }
        if (hipFuncSetAttribute((const void*)trunk_fwd, hipFuncAttributeMaxDynamicSharedMemorySize, LDS_BYTES) != hipSuccess) { fprintf(stderr, "kernel_launch: hipFuncSetAttribute failed\n"); grid = -1; return; }
        if (hipOccupancyMaxActiveBlocksPerMultiprocessor(&per_cu, (const void*)trunk_fwd, NWAVES * 64, LDS_BYTES) != hipSuccess || per_cu < 1)
            fprintf(stderr, "kernel_launch: occupancy query reports %d blocks per CU\n", per_cu);
        (void)hipGetLastError();
        grid = cus;
    }
    if (grid < 0) return;
    (void)hipMemsetAsync((char*)d_ws + WS_CTL, 0, CTL_ZERO_BYTES, stream);
    Args a{};
    for (int i = 0; i < 19; ++i) a.in[i] = (const float*)d_in[i];
    a.out = (float*)d_out; a.ws = (unsigned char*)d_ws;
#if MK_PER_PHASE
    for (int id = 0; id < N_PHASE_IDS; ++id) { if (!phase_exists(id)) continue; a.ph_lo = id; a.ph_hi = id + 1;
        hipLaunchKernelGGL(trunk_fwd, dim3(grid), dim3(NWAVES * 64), LDS_BYTES, stream, a); }
#else
    (void)phase_exists;
    a.ph_lo = 0; a.ph_hi = N_PHASE_IDS;
    hipLaunchKernelGGL(trunk_fwd, dim3(grid), dim3(NWAVES * 64), LDS_BYTES, stream, a);
#endif
    const hipError_t le = hipPeekAtLastError();
    if (le != hipSuccess) fprintf(stderr, "kernel_launch: launch failed: %s\n", hipGetErrorName(le));
}
```
